# Optimizing an MI355X kernel written in HIP

```python
import math
import jax, jax.numpy as jnp
from jax import lax
import numpy as np

D_MODEL = 1024
BATCH = 8
SEQ = 2048
DEPTH = 1
DEC_BATCH = 8
DEC_SEQ = 16
PAST_LEN = 2048

CHUNK = 64
N_HEADS = 16
N_KV_HEADS = 2
HEAD_DIM = 64
GROUP = N_HEADS // N_KV_HEADS
ATT_WIDTH = N_HEADS * HEAD_DIM
KV_WIDTH = N_KV_HEADS * HEAD_DIM
WINDOW = 128
WINDOW_CHUNKS = WINDOW // CHUNK
ATTN_SCALE = HEAD_DIM ** -0.5
N_BUCKETS = 32
MAX_DISTANCE = 128
HG_EXPAND = 128
HG_HEADS = D_MODEL // HG_EXPAND
HG_DK = HG_EXPAND
HG_DV = D_MODEL // HG_HEADS
HG_WIDTH = HG_HEADS * HG_DK
HG_VWIDTH = HG_HEADS * HG_DV
D_FF = -(-8 * D_MODEL // (3 * 256)) * 256
IN_WIDTH = ATT_WIDTH + 2 * KV_WIDTH + 2 * HG_WIDTH + 2 * HG_VWIDTH + 2 * D_MODEL
RMS_EPS = 1e-6

kernel_name = "hybrid_swa_hgrn2_streaming_step"


def _rmsnorm(x, w):
    xf = x.astype(jnp.float32)
    y = xf * lax.rsqrt(jnp.mean(xf * xf, axis=-1, keepdims=True) + RMS_EPS) * w.astype(jnp.float32)
    return y.astype(x.dtype)


def _split_proj(proj):
    sizes = (ATT_WIDTH, KV_WIDTH, KV_WIDTH, HG_WIDTH, HG_WIDTH, HG_VWIDTH, HG_VWIDTH, D_MODEL, D_MODEL)
    idx = np.cumsum(sizes)[:-1].tolist()
    return jnp.split(proj, idx, axis=-1)


def _t5_bucket(rel):
    nb = N_BUCKETS // 2
    max_exact = nb // 2
    ret = jnp.where(rel > 0, nb, 0)
    n = jnp.abs(rel)
    nf = jnp.maximum(n, 1).astype(jnp.float32)
    large = max_exact + (jnp.log(nf / max_exact) / math.log(MAX_DISTANCE / max_exact)
                         * (nb - max_exact)).astype(jnp.int32)
    large = jnp.minimum(large, nb - 1)
    return ret + jnp.where(n < max_exact, n, large)


def _rel_bias(table, cq, lk):
    rel = jnp.arange(lk, dtype=jnp.int32)[None, :] - WINDOW - jnp.arange(cq, dtype=jnp.int32)[:, None]
    b = table[_t5_bucket(rel)]
    return b.transpose(2, 0, 1).reshape(N_KV_HEADS, GROUP, cq, lk).astype(jnp.float32)


def _attend(q, k, v, sinks, bias, valid):
    s = jnp.einsum('bnqkgd,bnlkd->bnkgql', q, k).astype(jnp.float32) * ATTN_SCALE + bias
    s = jnp.where(valid[None, :, None, None], s, -jnp.inf)
    sink = sinks.astype(jnp.float32).reshape(N_KV_HEADS, GROUP)[None, None, :, :, None]
    m = jnp.maximum(jnp.max(s, axis=-1), sink)
    p = jnp.exp(s - m[..., None])
    denom = jnp.sum(p, axis=-1) + jnp.exp(sink - m)
    p = (p / denom[..., None]).astype(v.dtype)
    return jnp.einsum('bnkgql,bnlkd->bnqkgd', p, v)


def _hgrn_gates(hq, hf, hi, lb):
    b, t, _ = hq.shape
    f = lb + (1.0 - lb) * jax.nn.sigmoid(hf.astype(jnp.float32))

    def heads(a, d):
        return a.reshape(b, t, HG_HEADS, d).transpose(0, 2, 1, 3)

    return (heads(hq.astype(jnp.float32), HG_DK), heads(1.0 - f, HG_DK),
            heads(hi.astype(jnp.float32), HG_DV), heads(jnp.log(f), HG_DK))


def _hgrn_block(s0, q, k, v, logf):
    c = q.shape[2]
    bcum = jnp.cumsum(logf, axis=2)
    inter = jnp.einsum('bhtd,bhde->bhte', q * jnp.exp(bcum), s0)
    causal = (jnp.arange(c)[:, None] >= jnp.arange(c)[None, :])[None, None, :, :, None]
    decay = jnp.exp(jnp.where(causal, bcum[:, :, :, None, :] - bcum[:, :, None, :, :], -jnp.inf))
    a = jnp.einsum('bhtd,bhtsd,bhsd->bhts', q, decay, k)
    intra = jnp.einsum('bhts,bhse->bhte', a, v)
    blast = bcum[:, :, -1:, :]
    s_new = jnp.exp(blast[:, :, 0, :])[..., None] * s0 + jnp.einsum(
        'bhsd,bhse->bhde', k * jnp.exp(blast - bcum), v)
    return s_new, inter + intra


def _hgrn_readout(o, og, gnorm_w):
    b, _, t, _ = o.shape
    o = o.transpose(0, 2, 1, 3)
    o = o * lax.rsqrt(jnp.mean(o * o, axis=-1, keepdims=True) + RMS_EPS) * gnorm_w.astype(jnp.float32)
    o = o * jax.nn.silu(og.astype(jnp.float32).reshape(b, t, HG_HEADS, HG_DV))
    return o.reshape(b, t, HG_VWIDTH).astype(og.dtype)


def _merge(att, hg, ga, gh, w_out):
    return (jax.nn.sigmoid(ga) * att + jax.nn.sigmoid(gh) * hg) @ w_out


def _ffn(x, norm_w, w_gate_up, w_down):
    h = _rmsnorm(x, norm_w)
    g, u = jnp.split(h @ w_gate_up, 2, axis=-1)
    return (jax.nn.silu(g) * u) @ w_down


def _mixer_prompt(x, norm_w, w_in, w_out, sinks, rel_table, lb, gnorm_w):
    b, s, _ = x.shape
    n = s // CHUNK
    h = _rmsnorm(x, norm_w)
    q, k, v, hq, hf, hi, hog, ga, gh = _split_proj(h @ w_in)
    k = k.reshape(b, s, N_KV_HEADS, HEAD_DIM)
    v = v.reshape(b, s, N_KV_HEADS, HEAD_DIM)
    pad = ((0, 0), (WINDOW, 0), (0, 0), (0, 0))
    kp = jnp.pad(k, pad).reshape(b, n + WINDOW_CHUNKS, CHUNK, N_KV_HEADS, HEAD_DIM)
    vp = jnp.pad(v, pad).reshape(b, n + WINDOW_CHUNKS, CHUNK, N_KV_HEADS, HEAD_DIM)
    kw = jnp.concatenate([kp[:, j:j + n] for j in range(WINDOW_CHUNKS + 1)], axis=2)
    vw = jnp.concatenate([vp[:, j:j + n] for j in range(WINDOW_CHUNKS + 1)], axis=2)
    key_chunk = (jnp.arange(n)[:, None, None] - WINDOW_CHUNKS
                 + (jnp.arange(WINDOW + CHUNK) // CHUNK)[None, None, :])
    valid = key_chunk >= 0
    att = _attend(q.reshape(b, n, CHUNK, N_KV_HEADS, GROUP, HEAD_DIM), kw, vw, sinks,
                  _rel_bias(rel_table, CHUNK, WINDOW + CHUNK), valid).reshape(b, s, ATT_WIDTH)
    qh, kh, vh, lf = _hgrn_gates(hq, hf, hi, lb)

    def to_blocks(a):
        return a.reshape(b, HG_HEADS, n, CHUNK, a.shape[-1]).transpose(2, 0, 1, 3, 4)

    s0 = jnp.zeros((b, HG_HEADS, HG_DK, HG_DV), jnp.float32)
    s_fin, o = lax.scan(lambda st, blk: _hgrn_block(st, *blk), s0,
                        (to_blocks(qh), to_blocks(kh), to_blocks(vh), to_blocks(lf)))
    o = o.transpose(1, 2, 0, 3, 4).reshape(b, HG_HEADS, s, HG_DV)
    hg = _hgrn_readout(o, hog, gnorm_w)
    y = x + _merge(att, hg, ga, gh, w_out)
    return y, k[:, s - WINDOW:], v[:, s - WINDOW:], s_fin.astype(x.dtype)


def _mixer_sample(x, cache_k, cache_v, state, norm_w, w_in, w_out, sinks, rel_table, lb, gnorm_w):
    b, t, _ = x.shape
    h = _rmsnorm(x, norm_w)
    q, k, v, hq, hf, hi, hog, ga, gh = _split_proj(h @ w_in)
    k = k.reshape(b, t, N_KV_HEADS, HEAD_DIM)
    v = v.reshape(b, t, N_KV_HEADS, HEAD_DIM)
    k_all = jnp.concatenate([cache_k.astype(k.dtype), k], axis=1)
    v_all = jnp.concatenate([cache_v.astype(v.dtype), v], axis=1)
    valid = jnp.ones((1, 1, WINDOW + t), dtype=bool)
    att = _attend(q.reshape(b, 1, t, N_KV_HEADS, GROUP, HEAD_DIM), k_all[:, None], v_all[:, None],
                  sinks, _rel_bias(rel_table, t, WINDOW + t), valid).reshape(b, t, ATT_WIDTH)
    s_new, o = _hgrn_block(state.astype(jnp.float32), *_hgrn_gates(hq, hf, hi, lb))
    hg = _hgrn_readout(o, hog, gnorm_w)
    y = x + _merge(att, hg, ga, gh, w_out)
    return y, k_all[:, t:], v_all[:, t:], s_new.astype(x.dtype)


def setup_inputs(seed: int = 0) -> dict:
    key = jax.random.key(seed)
    ks = jax.random.split(key, 20)
    f32 = jnp.float32

    def nrm(k, shape, scale):
        return jax.random.normal(k, shape, f32) * scale

    return {
        "x_prompt": nrm(ks[0], (BATCH, SEQ, D_MODEL), 1.0),
        "x_sample": nrm(ks[1], (DEC_BATCH, DEC_SEQ, D_MODEL), 1.0),
        "cache_k": nrm(ks[2], (DEPTH, DEC_BATCH, WINDOW, N_KV_HEADS, HEAD_DIM), 1.0),
        "cache_v": nrm(ks[3], (DEPTH, DEC_BATCH, WINDOW, N_KV_HEADS, HEAD_DIM), 1.0),
        "state_hgrn": nrm(ks[4], (DEPTH, DEC_BATCH, HG_HEADS, HG_DK, HG_DV), 0.3),
        "norm_mix": 1.0 + nrm(ks[5], (DEPTH, D_MODEL), 0.01),
        "w_in": nrm(ks[6], (DEPTH, D_MODEL, IN_WIDTH), D_MODEL ** -0.5),
        "w_out": nrm(ks[7], (DEPTH, D_MODEL, D_MODEL), D_MODEL ** -0.5),
        "attn_sinks": nrm(ks[8], (DEPTH, N_HEADS), 0.5),
        "rel_bias_table": nrm(ks[9], (N_BUCKETS, N_HEADS), 0.1),
        "hgrn_lb": nrm(ks[10], (DEPTH + 1, HG_WIDTH), 0.1),
        "hgrn_norm": 1.0 + nrm(ks[11], (DEPTH, HG_DV), 0.01),
        "norm_ffn": 1.0 + nrm(ks[12], (DEPTH, D_MODEL), 0.01),
        "w_gate_up": nrm(ks[13], (DEPTH, D_MODEL, 2 * D_FF), D_MODEL ** -0.5),
        "w_down": nrm(ks[14], (DEPTH, D_FF, D_MODEL), D_FF ** -0.5),
        "norm_final": 1.0 + nrm(ks[15], (D_MODEL,), 0.01),
    }


def reference(x_prompt, x_sample, cache_k, cache_v, state_hgrn, norm_mix, w_in, w_out, attn_sinks,
              rel_bias_table, hgrn_lb, hgrn_norm, norm_ffn, w_gate_up, w_down, norm_final):
    lb_all = jnp.cumsum(jax.nn.softmax(hgrn_lb.astype(jnp.float32), axis=0), axis=0)
    xp, xs = x_prompt, x_sample
    nkp, nvp, nsp, nks, nvs, nss = [], [], [], [], [], []
    for l in range(DEPTH):
        xp, kp_, vp_, sp_ = _mixer_prompt(xp, norm_mix[l], w_in[l], w_out[l], attn_sinks[l],
                                          rel_bias_table, lb_all[l], hgrn_norm[l])
        xs, ks_, vs_, ss_ = _mixer_sample(xs, cache_k[l], cache_v[l], state_hgrn[l], norm_mix[l], w_in[l],
                                          w_out[l], attn_sinks[l], rel_bias_table, lb_all[l], hgrn_norm[l])
        xp = xp + _ffn(xp, norm_ffn[l], w_gate_up[l], w_down[l])
        xs = xs + _ffn(xs, norm_ffn[l], w_gate_up[l], w_down[l])
        nkp.append(kp_); nvp.append(vp_); nsp.append(sp_)
        nks.append(ks_); nvs.append(vs_); nss.append(ss_)
    y_prompt = _rmsnorm(xp, norm_final)
    y_sample = _rmsnorm(xs, norm_final)
    return (y_prompt, y_sample, jnp.stack(nkp), jnp.stack(nvp), jnp.stack(nsp),
            jnp.stack(nks), jnp.stack(nvs), jnp.stack(nss))
```

```cpp
#include <hip/hip_runtime.h>
#include <cstdio>
#include <cstdint>

#ifndef MK_N_LAUNCHES
#define MK_N_LAUNCHES 1
#endif

constexpr int O_YP = 0, O_YS = 16777216, O_KP = 16908288, O_VP = 17039360, O_SP = 17170432, O_KS = 18219008, O_VS = 18350080, O_SS = 18481152;
namespace pg8 {
#define PG8_LAS __attribute__((address_space(3)))
typedef unsigned short bf16_t;
typedef short bf16x8 __attribute__((ext_vector_type(8)));
typedef float f32x4 __attribute__((ext_vector_type(4)));
typedef unsigned u32x4 __attribute__((ext_vector_type(4)));
constexpr int BM = 256, BK = 64, HALF = 128, HTB = HALF * BK * 2, STAGE_BYTES = 8 * HTB, NXCD = 8, WGM = 8;

__host__ __device__ __forceinline__ int lds_byte(int r, int c) { const int st = (r >> 4) * 2 + (c >> 5), rr = r & 15, cc = c & 31, ob = rr * 64 + cc * 2; return st * 1024 + (ob ^ (((ob >> 9) & 1) << 5)); }
__host__ __device__ __forceinline__ void stage_rc(int b, int& R, int& C) { const int st = b / 1024, sb = b % 1024, swz = sb ^ (((sb >> 9) & 1) << 5); R = (st >> 1) * 16 + swz / 64; C = (st & 1) * 32 + (swz % 64) / 2; }
__host__ __device__ __forceinline__ int perm32(int rho) { const int n = rho >> 4, i = rho & 15; return 8 * (i >> 2) + 4 * n + (i & 3); }

struct Unit { int pm, pn; };
struct Gemm { const bf16_t* A; const bf16_t* Bt; int M, N, K; };

struct StaticOrder {
    int nM, nN, nwg, G, c;
    __host__ __device__ void init(int M, int N, int G_, int c_) { nM = M / BM; nN = N / BM; nwg = nM * nN; G = G_; c = c_; }
    __host__ __device__ bool next(int i, Unit& u) const {
        const long L = (long)i * G + c; if (L >= nwg) return false;
        int wgid = (int)L; { const int q = nwg / NXCD, r = nwg % NXCD, xcd = wgid % NXCD, off = wgid / NXCD; wgid = (xcd < r ? xcd * (q + 1) : r * (q + 1) + (xcd - r) * q) + off; }
        const int nig = WGM * nN, gid = wgid / nig, fm = gid * WGM, gsz = (nM - fm) < WGM ? (nM - fm) : WGM;
        u.pm = fm + ((wgid % nig) % gsz); u.pn = (wgid % nig) / gsz; return true;
    }
    __device__ __forceinline__ void a_ready(const Unit&) const {}
    __device__ __forceinline__ void done(const Unit&) const {}
};

__device__ __forceinline__ unsigned cvt_pk_bf16(float lo, float hi) { unsigned r; asm volatile("v_cvt_pk_bf16_f32 %0, %1, %2" : "=v"(r) : "v"(lo), "v"(hi)); return r; }


struct EpiProj {
    static constexpr bool PERM = true, AFTER_DRAIN = false;
    bf16_t* Q; bf16_t* KV; bf16_t* H0; size_t hstride; float* out; float qscale;
    __device__ __forceinline__ void operator()(const f32x4 (&acc)[2][2][4][2], const Unit& u, int wr, int wc, int fr, int fq) const {
        const int row0 = u.pm * BM + wr * 64 + fr;
        bf16_t* base; int ldc, c0; float sc = 1.f;
        if (u.pn < 4) { base = Q; ldc = 1024; c0 = u.pn * 256; sc = qscale; }
        else if (u.pn == 4) { base = KV; ldc = 256; c0 = 0; }
        else { const int t = (u.pn - 5) >> 2; base = H0 + (size_t)t * hstride; ldc = 1024; c0 = ((u.pn - 5) & 3) * 256; }
        const int col0 = c0 + wc * 32 + 8 * fq;
#pragma unroll
        for (int ai = 0; ai < 2; ++ai)
#pragma unroll
            for (int m = 0; m < 4; ++m) {
                const int row = row0 + ai * HALF + m * 16;
                bf16_t* rowp = base + (size_t)row * ldc + col0;
#pragma unroll
                for (int bj = 0; bj < 2; ++bj) {
                    const f32x4 v0 = acc[ai][bj][m][0] * sc, v1 = acc[ai][bj][m][1] * sc;
                    u32x4 w; w.x = cvt_pk_bf16(v0[0], v0[1]); w.y = cvt_pk_bf16(v0[2], v0[3]); w.z = cvt_pk_bf16(v1[0], v1[1]); w.w = cvt_pk_bf16(v1[2], v1[3]);
                    *(u32x4*)(rowp + bj * HALF) = w;
                }
                if (u.pn == 4) {
                    int orow = -1; int okb = 0, ovb = 0;
                    if (row < 16384) { const int t = row & 2047; if (t >= 1920) { orow = (row >> 11) * 128 + (t - 1920); okb = O_KP; ovb = O_VP; } }
                    else if (row < 16512) { const int rs = row - 16384; orow = (rs >> 4) * 128 + 112 + (rs & 15); okb = O_KS; ovb = O_VS; }
                    if (orow >= 0) {
                        float* kd = out + okb + (size_t)orow * 128 + wc * 32 + 8 * fq;
                        float* vd = out + ovb + (size_t)orow * 128 + wc * 32 + 8 * fq;
                        *(f32x4*)(kd) = acc[ai][0][m][0]; *(f32x4*)(kd + 4) = acc[ai][0][m][1];
                        *(f32x4*)(vd) = acc[ai][1][m][0]; *(f32x4*)(vd + 4) = acc[ai][1][m][1];
                    }
                }
            }
    }
};

struct EpiOut {
    static constexpr bool PERM = true, AFTER_DRAIN = true;
    const float* x; float* Y1; bf16_t* A2; const float* nw; float* rowsq;
    __device__ __forceinline__ void fused(f32x4 (&acc)[2][2][4][2], const Unit& u, int wr, int wc, int fr, int fq, PG8_LAS unsigned char* lds, int wid, int lane) const {
        PG8_LAS float* P = (PG8_LAS float*)lds;
        const int col0 = u.pn * BM + wc * 32 + 8 * fq;
        f32x4 nwv[2][2];
#pragma unroll
        for (int bj = 0; bj < 2; ++bj)
#pragma unroll
            for (int n = 0; n < 2; ++n) nwv[bj][n] = *(const f32x4*)(nw + col0 + bj * HALF + 4 * n);
#pragma unroll
        for (int ai = 0; ai < 2; ++ai)
#pragma unroll
            for (int m = 0; m < 4; ++m) {
                const int rl = ai * HALF + wr * 64 + m * 16 + fr; const size_t off = (size_t)(u.pm * BM + rl) * 1024 + col0;
                float s = 0.f;
#pragma unroll
                for (int bj = 0; bj < 2; ++bj) {
                    const f32x4 xa = *(const f32x4*)(x + off + bj * HALF), xb = *(const f32x4*)(x + off + bj * HALF + 4);
                    const f32x4 y0 = acc[ai][bj][m][0] + xa, y1 = acc[ai][bj][m][1] + xb;
                    *(f32x4*)(Y1 + off + bj * HALF) = y0; *(f32x4*)(Y1 + off + bj * HALF + 4) = y1;
                    s += (y0[0] * y0[0] + y0[1] * y0[1]) + (y0[2] * y0[2] + y0[3] * y0[3]) + (y1[0] * y1[0] + y1[1] * y1[1]) + (y1[2] * y1[2] + y1[3] * y1[3]);
                    const f32x4 a0 = y0 * nwv[bj][0], a1 = y1 * nwv[bj][1];
                    u32x4 w; w.x = cvt_pk_bf16(a0[0], a0[1]); w.y = cvt_pk_bf16(a0[2], a0[3]); w.z = cvt_pk_bf16(a1[0], a1[1]); w.w = cvt_pk_bf16(a1[2], a1[3]);
                    *(u32x4*)(A2 + off + bj * HALF) = w;
                }
                s += __shfl_xor(s, 16); s += __shfl_xor(s, 32);
                if (fq == 0) P[rl * 4 + wc] = s;
                asm volatile("" ::: "memory");
            }
        asm volatile("s_waitcnt lgkmcnt(0)" ::: "memory"); __builtin_amdgcn_s_barrier(); asm volatile("" ::: "memory");
        const int tid = wid * 64 + lane;
        if (tid < 256) { const float t = (P[tid * 4 + 0] + P[tid * 4 + 1]) + (P[tid * 4 + 2] + P[tid * 4 + 3]); rowsq[(size_t)(u.pm * BM + tid) * 4 + u.pn] = t; }
        asm volatile("s_waitcnt lgkmcnt(0)" ::: "memory"); __builtin_amdgcn_s_barrier(); asm volatile("" ::: "memory");
    }
};

struct EpiGU {
    static constexpr bool PERM = true, AFTER_DRAIN = false;
    bf16_t* ACT; const float* rowsq;
    __device__ __forceinline__ void operator()(const f32x4 (&acc)[2][2][4][2], const Unit& u, int wr, int wc, int fr, int fq) const {
        const int row0 = u.pm * BM + wr * 64 + fr, col0 = u.pn * HALF + wc * 32 + 8 * fq;
#pragma unroll
        for (int ai = 0; ai < 2; ++ai)
#pragma unroll
            for (int m = 0; m < 4; ++m) {
                const int row = row0 + ai * HALF + m * 16;
                const f32x4 p = *(const f32x4*)(rowsq + (size_t)row * 4);
                const float rstd = 1.0f / sqrtf(((p[0] + p[1]) + (p[2] + p[3])) * (1.0f / 1024.0f) + 1e-6f);
                float r[8];
#pragma unroll
                for (int n = 0; n < 2; ++n)
#pragma unroll
                    for (int i = 0; i < 4; ++i) {
                        const float g = acc[ai][0][m][n][i] * rstd, uu = acc[ai][1][m][n][i] * rstd;
                        const float sg = __builtin_amdgcn_rcpf(1.0f + __builtin_amdgcn_exp2f(-1.4426950408889634f * g));
                        r[n * 4 + i] = g * sg * uu;
                    }
                u32x4 w; w.x = cvt_pk_bf16(r[0], r[1]); w.y = cvt_pk_bf16(r[2], r[3]); w.z = cvt_pk_bf16(r[4], r[5]); w.w = cvt_pk_bf16(r[6], r[7]);
                *(u32x4*)(ACT + (size_t)row * 2816 + col0) = w;
            }
    }
};

struct EpiDown {
    static constexpr bool PERM = false, AFTER_DRAIN = false;
    float* Y;
    __device__ __forceinline__ void operator()(const f32x4 (&acc)[2][2][4][2], const Unit& u, int wr, int wc, int fr, int fq) const {
        const int row0 = u.pm * BM + wr * 64 + fr, col0 = u.pn * BM + wc * 32 + 4 * fq;
#pragma unroll
        for (int ai = 0; ai < 2; ++ai)
#pragma unroll
            for (int m = 0; m < 4; ++m) { float* rowp = Y + (size_t)(row0 + ai * HALF + m * 16) * 1024 + col0;
#pragma unroll
                for (int bj = 0; bj < 2; ++bj)
#pragma unroll
                    for (int n = 0; n < 2; ++n) { const f32x4 b = *(const f32x4*)(rowp + bj * HALF + n * 16); *(f32x4*)(rowp + bj * HALF + n * 16) = acc[ai][bj][m][n] + b; }
                if (m & 1) asm volatile("" ::: "memory"); }
    }
};

template <class Epi, class Sched, bool ALIGN_EPI = false, bool SP2 = false>
__device__ __forceinline__ void gemm_phase(PG8_LAS unsigned char* lds, const Gemm g, const Sched& S, const Epi& E) {
    const int tid = threadIdx.x, wid = __builtin_amdgcn_readfirstlane(tid >> 6), lane = tid & 63, wr = wid >> 2, wc = wid & 3, fr = lane & 15, fq = lane >> 4;
    const int K = g.K, nt = K / BK;
    unsigned voffA[2], voffB[2];
#pragma unroll
    for (int i = 0; i < 2; ++i) { int R, C; stage_rc(tid * 16 + i * 8192, R, C); const int Rb = Epi::PERM ? ((R & ~31) + perm32(R & 31)) : R;
        voffA[i] = (unsigned)(R * K + C) * 2u; voffB[i] = (unsigned)(Rb * K + C) * 2u; }
    const size_t kstep = (size_t)(BK * 2);
    const size_t hstep = (size_t)HALF * K * 2;
    const size_t tstep = 2 * hstep;
    const unsigned ldsw = (unsigned)wid * 1024u;
    const int aoff = lds_byte(wr * 64 + fr, fq * 8), boff = lds_byte(wc * 32 + fr, fq * 8);
#define PG8_SA(b, h) (((b) * 2 + (h)) * HTB)
#define PG8_SB(b, h) ((4 + (b) * 2 + (h)) * HTB)
#define PG8_STAGE(bufoff, gbase, voff) do { _Pragma("unroll") for (int _i = 0; _i < 2; ++_i) \
        __builtin_amdgcn_global_load_lds((const unsigned*)((const char*)(gbase) + (voff)[_i]), (PG8_LAS unsigned*)(lds + (bufoff) + ldsw + _i * 8192), 16, 0, 0); } while (0)
#define PG8_LDA(dst, b, h) do { _Pragma("unroll") for (int m = 0; m < 4; ++m) _Pragma("unroll") for (int k = 0; k < 2; ++k) dst[m][k] = *(const PG8_LAS bf16x8*)(lds + PG8_SA(b, h) + aoff + m * 2048 + k * 1024); } while (0)
#define PG8_LDB(dst, b, h) do { _Pragma("unroll") for (int n = 0; n < 2; ++n) _Pragma("unroll") for (int k = 0; k < 2; ++k) dst[n][k] = *(const PG8_LAS bf16x8*)(lds + PG8_SB(b, h) + boff + n * 2048 + k * 1024); } while (0)
#define PG8_MMA(ai, bj, At, Bt) do { __builtin_amdgcn_s_setprio(1); _Pragma("unroll") for (int m = 0; m < 4; ++m) _Pragma("unroll") for (int n = 0; n < 2; ++n) _Pragma("unroll") for (int k = 0; k < 2; ++k) \
        acc[ai][bj][m][n] = __builtin_amdgcn_mfma_f32_16x16x32_bf16(Bt[n][k], At[m][k], acc[ai][bj][m][n], 0, 0, 0); __builtin_amdgcn_s_setprio(0); } while (0)
#define PG8_WAIT_V(n) asm volatile("s_waitcnt vmcnt(" #n ")" ::: "memory")
#define PG8_WAIT_L(n) asm volatile("s_waitcnt lgkmcnt(" #n ")" ::: "memory")
#define PG8_BAR __builtin_amdgcn_s_barrier()
#define PG8_SCHED __builtin_amdgcn_sched_barrier(0)
    Unit cur, nxt; int ui = 0;
    if (!S.next(0, cur)) return;
    f32x4 acc[2][2][4][2];
#pragma unroll
    for (int a = 0; a < 2; ++a)
#pragma unroll
        for (int b = 0; b < 2; ++b)
#pragma unroll
            for (int m = 0; m < 4; ++m)
#pragma unroll
                for (int n = 0; n < 2; ++n) acc[a][b][m][n] = (f32x4){0.f, 0.f, 0.f, 0.f};
    bf16x8 At[4][2], B0[2][2], B1[2][2];
    const char* cA = (const char*)g.A + (size_t)cur.pm * tstep; const char* cB = (const char*)g.Bt + (size_t)cur.pn * tstep;
    S.a_ready(cur);
    if constexpr (SP2) {
        PG8_STAGE(PG8_SB(0, 0), cB, voffB); PG8_STAGE(PG8_SB(0, 1), cB + hstep, voffB); PG8_STAGE(PG8_SA(0, 0), cA, voffA); PG8_STAGE(PG8_SA(0, 1), cA + hstep, voffA);
        if (wr == 1) PG8_BAR;
        PG8_WAIT_V(2); PG8_BAR;
        PG8_STAGE(PG8_SB(1, 0), cB + kstep, voffB); PG8_STAGE(PG8_SA(1, 0), cA + kstep, voffA); PG8_STAGE(PG8_SB(1, 1), cB + hstep + kstep, voffB);
        PG8_WAIT_V(6); PG8_BAR;
    } else {
        PG8_STAGE(PG8_SB(0, 0), cB, voffB); PG8_STAGE(PG8_SA(0, 0), cA, voffA); PG8_STAGE(PG8_SB(0, 1), cB + hstep, voffB); PG8_STAGE(PG8_SA(0, 1), cA + hstep, voffA);
        if (wr == 1) PG8_BAR;
        PG8_WAIT_V(4); PG8_BAR;
        PG8_STAGE(PG8_SB(1, 0), cB + kstep, voffB); PG8_STAGE(PG8_SA(1, 0), cA + kstep, voffA); PG8_STAGE(PG8_SB(1, 1), cB + hstep + kstep, voffB);
        PG8_WAIT_V(6); PG8_BAR;
    }
    for (;;) {
        const bool has_next = S.next(ui + 1, nxt);
        const char* nA = has_next ? (const char*)g.A + (size_t)nxt.pm * tstep : cA; const char* nB = has_next ? (const char*)g.Bt + (size_t)nxt.pn * tstep : cB;
        for (int t = 0; t < nt; t += 2) {
            const bool last = (t == nt - 2);
            const char* a1 = cA + (size_t)(t + 1) * kstep;
            const char* a2 = last ? nA : cA + (size_t)(t + 2) * kstep; const char* b2 = last ? nB : cB + (size_t)(t + 2) * kstep;
            const char* a3 = a2 + kstep; const char* b3 = b2 + kstep;
            if (last && has_next) S.a_ready(nxt);
            if constexpr (SP2) {
            PG8_LDB(B0, 0, 0); PG8_LDB(B1, 0, 1); PG8_SCHED; PG8_LDA(At, 0, 0); PG8_STAGE(PG8_SA(1, 1), a1 + hstep, voffA);
            PG8_WAIT_V(8); PG8_WAIT_L(0); PG8_BAR; PG8_MMA(0, 0, At, B0); PG8_MMA(0, 1, At, B1); PG8_BAR; PG8_SCHED;
            PG8_LDA(At, 0, 1); PG8_STAGE(PG8_SB(0, 0), b2, voffB); PG8_STAGE(PG8_SB(0, 1), b2 + hstep, voffB); PG8_STAGE(PG8_SA(0, 0), a2, voffA);
            PG8_WAIT_V(8); PG8_WAIT_L(0); PG8_BAR; PG8_MMA(1, 0, At, B0); PG8_MMA(1, 1, At, B1); PG8_BAR; PG8_SCHED;
            PG8_LDB(B0, 1, 0); PG8_LDB(B1, 1, 1); PG8_SCHED; PG8_LDA(At, 1, 0); PG8_STAGE(PG8_SA(0, 1), a2 + hstep, voffA);
            PG8_WAIT_V(8); PG8_WAIT_L(0); PG8_BAR; PG8_MMA(0, 0, At, B0); PG8_MMA(0, 1, At, B1); PG8_BAR; PG8_SCHED;
            PG8_LDA(At, 1, 1); PG8_STAGE(PG8_SB(1, 0), b3, voffB); PG8_STAGE(PG8_SB(1, 1), b3 + hstep, voffB); PG8_STAGE(PG8_SA(1, 0), a3, voffA);
            PG8_WAIT_V(8); PG8_WAIT_L(0); PG8_BAR; PG8_MMA(1, 0, At, B0); PG8_MMA(1, 1, At, B1); PG8_BAR; PG8_SCHED;
            } else {
            PG8_LDB(B0, 0, 0); PG8_SCHED; PG8_LDA(At, 0, 0); PG8_STAGE(PG8_SA(1, 1), a1 + hstep, voffA);
            PG8_WAIT_L(8); PG8_BAR; PG8_WAIT_L(0); PG8_MMA(0, 0, At, B0); PG8_BAR; PG8_SCHED;
            PG8_LDB(B1, 0, 1); PG8_STAGE(PG8_SB(0, 0), b2, voffB);
            PG8_BAR; PG8_WAIT_L(0); PG8_MMA(0, 1, At, B1); PG8_BAR;
            PG8_LDA(At, 0, 1); PG8_STAGE(PG8_SA(0, 0), a2, voffA);
            PG8_BAR; PG8_WAIT_L(0); PG8_MMA(1, 0, At, B0); PG8_BAR; PG8_SCHED;
            PG8_STAGE(PG8_SB(0, 1), b2 + hstep, voffB);
            PG8_WAIT_V(6); PG8_BAR; PG8_MMA(1, 1, At, B1); PG8_BAR;
            PG8_LDB(B0, 1, 0); PG8_SCHED; PG8_LDA(At, 1, 0); PG8_STAGE(PG8_SA(0, 1), a2 + hstep, voffA);
            PG8_WAIT_L(8); PG8_BAR; PG8_WAIT_L(0); PG8_MMA(0, 0, At, B0); PG8_BAR; PG8_SCHED;
            PG8_LDB(B1, 1, 1); PG8_STAGE(PG8_SB(1, 0), b3, voffB);
            PG8_BAR; PG8_WAIT_L(0); PG8_MMA(0, 1, At, B1); PG8_BAR;
            PG8_LDA(At, 1, 1); PG8_STAGE(PG8_SA(1, 0), a3, voffA);
            PG8_BAR; PG8_WAIT_L(0); PG8_MMA(1, 0, At, B0); PG8_BAR; PG8_SCHED;
            PG8_STAGE(PG8_SB(1, 1), b3 + hstep, voffB);
            PG8_WAIT_V(6); PG8_BAR; PG8_MMA(1, 1, At, B1); PG8_BAR;
            }
        }
        if constexpr (ALIGN_EPI) { if (wr == 0) PG8_BAR; }
        if constexpr (!Epi::AFTER_DRAIN) { E(acc, cur, wr, wc, fr, fq); S.done(cur); }
        if (!has_next) break;
#pragma unroll
        for (int a = 0; a < 2; ++a)
#pragma unroll
            for (int b = 0; b < 2; ++b)
#pragma unroll
                for (int m = 0; m < 4; ++m)
#pragma unroll
                    for (int n = 0; n < 2; ++n) acc[a][b][m][n] = (f32x4){0.f, 0.f, 0.f, 0.f};
        cur = nxt; cA = nA; cB = nB; ++ui;
        if constexpr (ALIGN_EPI) { if (wr == 1) PG8_BAR; }
    }
    PG8_WAIT_V(0);
    if constexpr (!ALIGN_EPI) { if (wr == 0) PG8_BAR; }
    PG8_BAR;
    if constexpr (Epi::AFTER_DRAIN) { E.fused(acc, cur, wr, wc, fr, fq, lds, wid, lane); S.done(cur); }
#undef PG8_SA
#undef PG8_SB
#undef PG8_STAGE
#undef PG8_LDA
#undef PG8_LDB
#undef PG8_MMA
#undef PG8_WAIT_V
#undef PG8_WAIT_L
#undef PG8_BAR
#undef PG8_SCHED
}
}

constexpr int NWAVES = 8;
constexpr int N_LAUNCHES = MK_N_LAUNCHES;
constexpr int PER_PHASE = 8;
constexpr int D = 1024, NBATCH = 8, SEQ = 2048, MP = NBATCH * SEQ, MS = 128, MROWS = 16640;
constexpr int NIN = 7424, DFF = 2816, NGU = 5632;
constexpr float RMS_EPS = 1e-6f;
constexpr float LOG2E = 1.4426950408889634f;
constexpr float C2 = 0.125f * LOG2E;

constexpr size_t MiB = 1u << 20;
constexpr size_t ACTB = (size_t)MROWS * 1024 * 2;
constexpr size_t WS_CTL = 0, CTL_ZERO_BYTES = 1 * MiB;
constexpr size_t WS_WIN = 1 * MiB;
constexpr size_t WS_Q = 16 * MiB;
constexpr size_t WS_KV = WS_Q + ACTB;
constexpr size_t WS_HQ = WS_KV + 8 * MiB + MiB / 2;
constexpr size_t WS_HF = WS_HQ + ACTB, WS_HI = WS_HF + ACTB, WS_HOG = WS_HI + ACTB, WS_GA = WS_HOG + ACTB, WS_GH = WS_GA + ACTB;
constexpr size_t WS_MISC = WS_GH + ACTB;
constexpr size_t WS_A2 = WS_HQ;
constexpr size_t WS_ACT = WS_HF;
constexpr size_t WS_WOUT = WS_GA;
constexpr size_t WS_WGU = WS_WOUT + 2 * MiB, WS_WDN = WS_WGU + 11 * MiB;
static_assert(WS_WDN + (size_t)1024 * 2816 * 2 <= WS_GH, "late weights inside GA");
static_assert(WS_ACT + (size_t)MROWS * DFF * 2 <= WS_GA, "ACT inside HF..HOG");
constexpr size_t WS_BIAS = WS_MISC;
constexpr size_t WS_SINK = WS_BIAS + 16 * 256 * 4;
constexpr size_t WS_LB = WS_SINK + 256;
constexpr size_t WS_ROWSQ = WS_MISC + 64 * 1024;
constexpr size_t WS_Y1S = WS_MISC + 512 * 1024;
constexpr size_t WS_END = WS_MISC + 2 * MiB;
static_assert(WS_END <= 256 * MiB, "d_ws map");

constexpr int CW_TMO = 0, CW_CODE = 1, CW_BAR = 4096;

constexpr int RING_BYTES = 131072;
constexpr int LDSCTL_OFF = RING_BYTES, MISC_OFF = LDSCTL_OFF + 320;
constexpr int LDS_BYTES = 147456;

#define GAS __attribute__((address_space(1)))
#define LAS __attribute__((address_space(3)))
typedef unsigned short bf16;
typedef unsigned v4u __attribute__((ext_vector_type(4)));
typedef float f32x4 __attribute__((ext_vector_type(4)));
typedef short bf16x8 __attribute__((ext_vector_type(8)));
typedef GAS unsigned gu32;
#define RLX_AGENT __ATOMIC_RELAXED, __HIP_MEMORY_SCOPE_AGENT
#define LDS_WAIT() asm volatile("s_waitcnt lgkmcnt(0)" ::: "memory")
#define VM_WAIT() asm volatile("s_waitcnt vmcnt(0)" ::: "memory")
__device__ __forceinline__ unsigned f2bf(float f) { unsigned u = __builtin_bit_cast(unsigned, f); return (u + 0x7fffu + ((u >> 16) & 1u)) >> 16; }
__device__ __forceinline__ unsigned pk2(float lo, float hi) { return f2bf(lo) | (f2bf(hi) << 16); }
__device__ __forceinline__ float bf2f(unsigned short h) { return __builtin_bit_cast(float, (unsigned)h << 16); }
__device__ __forceinline__ float bflo(unsigned w) { return __builtin_bit_cast(float, w << 16); }
__device__ __forceinline__ float bfhi(unsigned w) { return __builtin_bit_cast(float, w & 0xffff0000u); }
__device__ __forceinline__ float sigmoidf_(float v) { return 1.0f / (1.0f + __expf(-v)); }

#define XB_TMO      128
#define XB_XCNT(j)  (256  + 64 * (j))
#define XB_XSUB(j)  (1280 + 64 * (j))
#define XB_XGEN(j)  (2304 + 64 * (j))
#define XB_TOP      3328
#define XB_TOPGEN   3392
#define XCD_BAR_WORDS 3456
#define XB_SPIN_CAP (1u << 18)
__device__ __forceinline__ unsigned xb_ld(unsigned* p)              { return __hip_atomic_load(p, __ATOMIC_RELAXED, __HIP_MEMORY_SCOPE_AGENT); }
__device__ __forceinline__ unsigned xb_add(unsigned* p, unsigned v) { return __hip_atomic_fetch_add(p, v, __ATOMIC_RELAXED, __HIP_MEMORY_SCOPE_AGENT); }
__device__ __forceinline__ unsigned xb_xcc_id() { return (unsigned)__builtin_amdgcn_s_getreg((3 << 11) | 20) & 0xFu; }
#define XB_SPIN(cond, bar) do { unsigned _sp = 0; while (cond) { __builtin_amdgcn_s_sleep(1); \
    if ((++_sp & 255u) == 0u) { if (xb_ld(&(bar)[XB_TMO])) break; if (_sp > XB_SPIN_CAP) { atomicAdd(&(bar)[XB_TMO], 1u); break; } } } } while (0)
struct XcdBarrier { unsigned* bar; unsigned x; volatile LAS unsigned* st; };
__device__ __forceinline__ XcdBarrier xcd_barrier_post(unsigned* bar, volatile LAS unsigned* st) {
    XcdBarrier b; b.bar = bar; b.x = xb_xcc_id(); b.st = st;
    if (threadIdx.x == 0) (void)xb_add(&bar[XB_XCNT(b.x)], 1u);
    return b;
}
__device__ __forceinline__ void xcd_barrier_complete(unsigned* bar, unsigned x, unsigned& nloc, unsigned& nx) {
    const unsigned G = gridDim.x * gridDim.y * gridDim.z;
    unsigned sum, cnt, mine, sp = 0u;
    for (;;) {
        sum = 0u; cnt = 0u; mine = 0u;
#pragma unroll
        for (unsigned j = 0; j < 16; ++j) { const unsigned c = xb_ld(&bar[XB_XCNT(j)]); sum += c; cnt += (c > 0u) ? 1u : 0u; mine = (j == x) ? c : mine; }
        if (sum == G) break;
        __builtin_amdgcn_s_sleep(1);
        if ((++sp & 255u) == 0u) { if (xb_ld(&bar[XB_TMO])) break; if (sp > XB_SPIN_CAP) { atomicAdd(&bar[XB_TMO], 1u); break; } }
    }
    nloc = mine > 0u ? mine : 1u; nx = cnt > 0u ? cnt : 1u;
}
__device__ __forceinline__ void xcd_barrier(const XcdBarrier& b) {
    asm volatile("s_waitcnt vmcnt(0)" ::: "memory");
    __syncthreads();
    if (threadIdx.x == 0) {
        unsigned* bar = b.bar;
        __builtin_amdgcn_s_waitcnt(0);
        unsigned nloc = b.st[0], nx = b.st[1];
        if (nloc == 0u) { xcd_barrier_complete(bar, b.x, nloc, nx); b.st[0] = nloc; b.st[1] = nx; }
        const unsigned old = xb_add(&bar[XB_XSUB(b.x)], 1u);
        const unsigned gen = old / nloc;
        if (old + 1u == (gen + 1u) * nloc) {
            __builtin_amdgcn_fence(__ATOMIC_RELEASE, "agent");
            asm volatile("s_waitcnt vmcnt(0)" ::: "memory");
            const unsigned og = xb_add(&bar[XB_TOP], 1u);
            const unsigned tg = og / nx;
            if (og + 1u == (tg + 1u) * nx) xb_add(&bar[XB_TOPGEN], 1u);
            else XB_SPIN(xb_ld(&bar[XB_TOPGEN]) == tg, bar);
            __builtin_amdgcn_fence(__ATOMIC_ACQUIRE, "agent");
            xb_add(&bar[XB_XGEN(b.x)], 1u);
            asm volatile("s_waitcnt vmcnt(0)" ::: "memory");
        } else {
            XB_SPIN(xb_ld(&bar[XB_XGEN(b.x)]) == gen, bar);
            __builtin_amdgcn_fence(__ATOMIC_ACQUIRE, "agent");
            asm volatile("s_waitcnt vmcnt(0)" ::: "memory");
        }
    }
    __syncthreads();
}

__device__ __forceinline__ float wave_sum(float v) {
#pragma unroll
    for (int o = 1; o < 64; o <<= 1) v += __shfl_xor(v, o);
    return v;
}
__device__ __forceinline__ void transpose_item(const float* W, int K, int N, bf16* WT, int k0, int src_n0, int dst_n0, LAS float* scr, int lane) {
#pragma unroll 8
    for (int i = 0; i < 32; ++i) { const int kk = 2 * i + (lane >> 5); scr[kk * 33 + (lane & 31)] = W[(size_t)(k0 + kk) * N + src_n0 + (lane & 31)]; }
    LDS_WAIT(); asm volatile("" ::: "memory");
    const int c = lane & 7;
#pragma unroll
    for (int j = 0; j < 4; ++j) { const int n = (lane >> 3) + 8 * j; const LAS float* s = scr + (8 * c) * 33 + n;
        v4u o; o.x = pk2(s[0 * 33], s[1 * 33]); o.y = pk2(s[2 * 33], s[3 * 33]); o.z = pk2(s[4 * 33], s[5 * 33]); o.w = pk2(s[6 * 33], s[7 * 33]);
        *(GAS v4u*)(WT + (size_t)(dst_n0 + n) * K + k0 + 8 * c) = o; }
    LDS_WAIT(); asm volatile("" ::: "memory");
}
__device__ __forceinline__ void rms_row_to_bf16(const float* xrow, const float* nw, bf16* orow, int lane) {
    const GAS f32x4* xr = (const GAS f32x4*)xrow + lane; const GAS f32x4* wr4 = (const GAS f32x4*)nw + lane;
    f32x4 v[4]; float s = 0.f;
#pragma unroll
    for (int j = 0; j < 4; ++j) { v[j] = xr[64 * j]; s += (v[j].x * v[j].x + v[j].y * v[j].y) + (v[j].z * v[j].z + v[j].w * v[j].w); }
    const float rstd = 1.f / sqrtf(wave_sum(s) * (1.f / D) + RMS_EPS);
    GAS unsigned long long* o8 = (GAS unsigned long long*)orow + lane;
#pragma unroll
    for (int j = 0; j < 4; ++j) { const f32x4 w = wr4[64 * j];
        o8[64 * j] = (unsigned long long)pk2(v[j].x * rstd * w.x, v[j].y * rstd * w.y) | ((unsigned long long)pk2(v[j].z * rstd * w.z, v[j].w * rstd * w.w) << 32); }
}
__device__ __forceinline__ void rms_row_f32(const float* xrow, const float* nw, float* orow, int lane) {
    const GAS f32x4* xr = (const GAS f32x4*)xrow + lane; const GAS f32x4* wr4 = (const GAS f32x4*)nw + lane;
    f32x4 v[4]; float s = 0.f;
#pragma unroll
    for (int j = 0; j < 4; ++j) { v[j] = xr[64 * j]; s += (v[j].x * v[j].x + v[j].y * v[j].y) + (v[j].z * v[j].z + v[j].w * v[j].w); }
    const float rstd = 1.f / sqrtf(wave_sum(s) * (1.f / D) + RMS_EPS);
    GAS f32x4* o4 = (GAS f32x4*)orow + lane;
#pragma unroll
    for (int j = 0; j < 4; ++j) { const f32x4 w = wr4[64 * j]; o4[64 * j] = v[j] * rstd * w; }
}
__device__ __forceinline__ int t5_bucket(int rel) {
    const int ret = rel > 0 ? 16 : 0; const int n = rel < 0 ? -rel : rel;
    int b;
    if (n < 8) b = n; else if (n < 12) b = 8; else if (n < 16) b = 9; else if (n < 23) b = 10; else if (n < 32) b = 11; else if (n < 46) b = 12; else if (n < 64) b = 13; else if (n < 91) b = 14; else b = 15;
    return ret + b;
}

struct Args { const float* in[16]; float* out; unsigned char* ws; int ph_lo, ph_hi, li, pad; };

template <int MODE>
__device__ __forceinline__ void skinny_item(int item, const bf16* A, const bf16* Bt, int K, const float* xs, float* Y1S, bf16* A2s, const float* nw, float* rowsq_s, float* outs,
                                            LAS unsigned char* lds, int wave, int lane) {
    const int rg = item >> 2, cb = item & 3; const int fr = lane & 15, fq = lane >> 4;
    const bf16* ap = A + (size_t)(rg * 16 + fr) * K + fq * 8;
    const bf16* bp0 = Bt + (size_t)(cb * 256 + wave * 32 + fr) * K + fq * 8;
    const bf16* bp1 = bp0 + (size_t)16 * K;
    f32x4 acc0 = {0.f, 0.f, 0.f, 0.f}, acc1 = {0.f, 0.f, 0.f, 0.f};
#pragma unroll 4
    for (int k = 0; k < K; k += 32) {
        const bf16x8 a = *(const bf16x8*)(ap + k), b0 = *(const bf16x8*)(bp0 + k), b1 = *(const bf16x8*)(bp1 + k);
        acc0 = __builtin_amdgcn_mfma_f32_16x16x32_bf16(a, b0, acc0, 0, 0, 0);
        acc1 = __builtin_amdgcn_mfma_f32_16x16x32_bf16(a, b1, acc1, 0, 0, 0);
    }
    LAS float* P = (LAS float*)lds;
    float ssq[4];
#pragma unroll
    for (int r = 0; r < 4; ++r) {
        const int row = rg * 16 + fq * 4 + r; const int c0 = cb * 256 + wave * 32 + fr, c1 = c0 + 16;
        if (MODE == 0) {
            const float y0 = xs[(size_t)row * 1024 + c0] + acc0[r], y1 = xs[(size_t)row * 1024 + c1] + acc1[r];
            Y1S[(size_t)row * 1024 + c0] = y0; Y1S[(size_t)row * 1024 + c1] = y1;
            A2s[(size_t)row * 1024 + c0] = (bf16)f2bf(y0 * nw[c0]); A2s[(size_t)row * 1024 + c1] = (bf16)f2bf(y1 * nw[c1]);
            ssq[r] = y0 * y0 + y1 * y1;
        } else {
            outs[(size_t)row * 1024 + c0] = Y1S[(size_t)row * 1024 + c0] + acc0[r];
            outs[(size_t)row * 1024 + c1] = Y1S[(size_t)row * 1024 + c1] + acc1[r];
            ssq[r] = 0.f;
        }
    }
    if (MODE == 0) {
#pragma unroll
        for (int r = 0; r < 4; ++r) { float s = ssq[r]; s += __shfl_xor(s, 1); s += __shfl_xor(s, 2); s += __shfl_xor(s, 4); s += __shfl_xor(s, 8); if (fr == 0) P[(fq * 4 + r) * 8 + wave] = s; }
        LDS_WAIT(); __syncthreads();
        if (wave == 0 && lane < 16) { float t = 0.f;
#pragma unroll
            for (int w = 0; w < 8; ++w) t += P[lane * 8 + w];
            rowsq_s[(size_t)(rg * 16 + lane) * 4 + cb] = t; }
        LDS_WAIT(); __syncthreads();
    }
}

__global__ void __launch_bounds__(NWAVES * 64, 2) mk_fwd(Args args) {
    extern __shared__ __attribute__((aligned(16))) unsigned char lds[];
    LAS unsigned char* L = (LAS unsigned char*)lds;
    volatile LAS unsigned* MISC = (volatile LAS unsigned*)(L + MISC_OFF);
    const int tid = threadIdx.x, lane = tid & 63, wave = __builtin_amdgcn_readfirstlane(tid >> 6);
    const int G = gridDim.x; const int bx = blockIdx.x;
    const int vcu = (G % 8 == 0) ? (bx % 8) * (G / 8) + bx / 8 : bx;
    unsigned char* ws = args.ws;
    gu32* ctl = (gu32*)(ws + WS_CTL);
    const float* x_prompt = args.in[0]; const float* x_sample = args.in[1]; const float* cache_k = args.in[2]; const float* cache_v = args.in[3];
    const float* state_in = args.in[4]; const float* norm_mix = args.in[5]; const float* w_in = args.in[6]; const float* w_out = args.in[7];
    const float* sinks = args.in[8]; const float* rel_tab = args.in[9]; const float* hgrn_lb = args.in[10]; const float* hgrn_norm = args.in[11];
    const float* norm_ffn = args.in[12]; const float* w_gu = args.in[13]; const float* w_dn = args.in[14]; const float* norm_final = args.in[15];
    float* out = args.out;
    bf16* WinT = (bf16*)(ws + WS_WIN); bf16* WoutT = (bf16*)(ws + WS_WOUT); bf16* WguT = (bf16*)(ws + WS_WGU); bf16* WdnT = (bf16*)(ws + WS_WDN);
    bf16* QB = (bf16*)(ws + WS_Q); bf16* KVB = (bf16*)(ws + WS_KV); bf16* HQB = (bf16*)(ws + WS_HQ); bf16* HFB = (bf16*)(ws + WS_HF); bf16* HIB = (bf16*)(ws + WS_HI);
    bf16* HOGB = (bf16*)(ws + WS_HOG); bf16* GAB = (bf16*)(ws + WS_GA); bf16* GHB = (bf16*)(ws + WS_GH);
    bf16* A2B = (bf16*)(ws + WS_A2); bf16* ACTB_ = (bf16*)(ws + WS_ACT);
    bf16* XN = (bf16*)out;
    float* BIAS2 = (float*)(ws + WS_BIAS); float* SINK2 = (float*)(ws + WS_SINK); float* LBV = (float*)(ws + WS_LB);
    float* ROWSQ = (float*)(ws + WS_ROWSQ); float* Y1S = (float*)(ws + WS_Y1S);

    for (int u = tid; u < (LDS_BYTES - LDSCTL_OFF) / 4; u += NWAVES * 64) ((LAS unsigned*)(L + LDSCTL_OFF))[u] = 0u;
    __syncthreads();
    XcdBarrier bar; bar.bar = (unsigned*)(ctl + CW_BAR); bar.x = 0; bar.st = nullptr;
    if (N_LAUNCHES != PER_PHASE) bar = xcd_barrier_post((unsigned*)(ctl + CW_BAR), MISC + 8);
#define GRID_BAR() do { if (N_LAUNCHES != PER_PHASE) { xcd_barrier(bar); } } while (0)
    const int lo = args.ph_lo, hi = args.ph_hi;
#define IN(k) (lo <= (k) && (k) < hi)
#define BOTH(k) (IN(k) && IN((k) + 1))
    const int gw = vcu * NWAVES + wave, NGW = G * NWAVES;

    if (IN(0)) {
        LAS float* scr = (LAS float*)(L + wave * 16384);
        constexpr int I_IN = (D / 64) * (NIN / 32);
        for (int it = gw; it < I_IN; it += NGW) { const int nblk = NIN / 32, kb = it / nblk, nb = it % nblk; transpose_item(w_in, D, NIN, WinT, 64 * kb, 32 * nb, 32 * nb, scr, lane); }
        for (int m = gw; m < MROWS; m += NGW) {
            if (m < MP) rms_row_to_bf16(x_prompt + (size_t)m * D, norm_mix, XN + (size_t)m * D, lane);
            else if (m < MP + MS) rms_row_to_bf16(x_sample + (size_t)(m - MP) * D, norm_mix, XN + (size_t)m * D, lane);
            else { GAS unsigned long long* o8 = (GAS unsigned long long*)(XN + (size_t)m * D) + lane;
#pragma unroll
                for (int j = 0; j < 4; ++j) o8[64 * j] = 0ull; }
        }
        const int gt = vcu * (NWAVES * 64) + tid, NGT = G * NWAVES * 64;
        for (int i = gt; i < 16 * 256; i += NGT) { const int h = i >> 8, idx = i & 255; const int rel = idx - 191; BIAS2[i] = (idx < 255) ? rel_tab[t5_bucket(rel) * 16 + h] * LOG2E : 0.f; }
        for (int i = gt; i < 16; i += NGT) SINK2[i] = sinks[i] * LOG2E;
        for (int i = gt; i < 1024; i += NGT) LBV[i] = 1.0f / (1.0f + __expf(hgrn_lb[1024 + i] - hgrn_lb[i]));
        for (int i = gt; i < 8 * 112 * 32; i += NGT) {
            const int b = i / (112 * 32), r = i % (112 * 32), j = r >> 5, c4 = r & 31;
            const f32x4 kv = *(const f32x4*)(cache_k + ((size_t)(b * 128 + 16 + j) * 128 + c4 * 4));
            const f32x4 vv = *(const f32x4*)(cache_v + ((size_t)(b * 128 + 16 + j) * 128 + c4 * 4));
            *(f32x4*)(out + O_KS + ((size_t)(b * 128 + j) * 128 + c4 * 4)) = kv;
            *(f32x4*)(out + O_VS + ((size_t)(b * 128 + j) * 128 + c4 * 4)) = vv;
        }
        for (int i = gt; i < MROWS * 4; i += NGT) ROWSQ[i] = 0.f;
        if (BOTH(0)) GRID_BAR();
    }

    if (IN(1)) {
        pg8::Gemm g{XN, WinT, MROWS, NIN, D}; pg8::StaticOrder S; S.init(MROWS, NIN, G, bx);
        pg8::EpiProj E{QB, KVB, HQB, ACTB / 2, out, C2};
        pg8::gemm_phase<pg8::EpiProj, pg8::StaticOrder, true, true>(L, g, S, E);
        if (BOTH(1)) GRID_BAR();
    }

    if (IN(2)) {
        LAS float* Ks = (LAS float*)L;
        LAS float* Vs = Ks + 192 * 64;
        LAS float* Bs = Vs + 192 * 64;
        for (int unit = vcu; unit < 512 + 16; unit += G) {
            int qrow0, nq, nk, jstart, kvh, b; bool samp = unit >= 512;
            if (!samp) { b = unit >> 6; const int c = (unit >> 1) & 31; kvh = unit & 1; qrow0 = b * SEQ + c * 64; nq = 64; nk = 192; jstart = c >= 2 ? 0 : (2 - c) * 64; }
            else { const int us = unit - 512; b = us >> 1; kvh = us & 1; qrow0 = MP + b * 16; nq = 16; nk = 144; jstart = 0; }
            __syncthreads();
            for (int i = tid; i < nk * 16; i += 512) {
                const int j = i >> 4, c4 = (i & 15) * 4;
                f32x4 kf, vf;
                if (samp && j < 128) {
                    kf = *(const f32x4*)(cache_k + ((size_t)(b * 128 + j) * 128 + kvh * 64 + c4));
                    vf = *(const f32x4*)(cache_v + ((size_t)(b * 128 + j) * 128 + kvh * 64 + c4));
                } else if (j >= jstart) {
                    const size_t row = samp ? (size_t)(MP + b * 16 + (j - 128)) : (size_t)(qrow0 - 128 + j);
                    const uint2 kw = *(const uint2*)(KVB + row * 256 + kvh * 64 + c4); const uint2 vw = *(const uint2*)(KVB + row * 256 + 128 + kvh * 64 + c4);
                    kf = (f32x4){bflo(kw.x), bfhi(kw.x), bflo(kw.y), bfhi(kw.y)}; vf = (f32x4){bflo(vw.x), bfhi(vw.x), bflo(vw.y), bfhi(vw.y)};
                } else { kf = (f32x4){0.f, 0.f, 0.f, 0.f}; vf = kf; }
                *(LAS f32x4*)(Ks + j * 64 + c4) = kf; *(LAS f32x4*)(Vs + j * 64 + c4) = vf;
            }
            for (int i = tid; i < 8 * 256; i += 512) Bs[i] = BIAS2[(kvh * 8 + (i >> 8)) * 256 + (i & 255)];
            __syncthreads();
            const int g8 = wave, qi = lane; const int h16 = kvh * 8 + g8;
            if (qi < nq) {
                const size_t row = (size_t)(qrow0 + qi);
                float q[64];
#pragma unroll
                for (int c = 0; c < 8; ++c) { const v4u w = *(const v4u*)(QB + row * 1024 + h16 * 64 + c * 8);
                    q[c * 8 + 0] = bflo(w.x); q[c * 8 + 1] = bfhi(w.x); q[c * 8 + 2] = bflo(w.y); q[c * 8 + 3] = bfhi(w.y); q[c * 8 + 4] = bflo(w.z); q[c * 8 + 5] = bfhi(w.z); q[c * 8 + 6] = bflo(w.w); q[c * 8 + 7] = bfhi(w.w); }
                const float sk = SINK2[h16];
                float mx = sk;
                const LAS float* brow = Bs + g8 * 256 + 63 - qi;
                for (int j = jstart; j < nk; ++j) {
                    float s = 0.f; const LAS f32x4* kr = (const LAS f32x4*)(Ks + j * 64);
#pragma unroll
                    for (int c = 0; c < 16; ++c) { const f32x4 kk = kr[c]; s += q[c * 4] * kk.x + q[c * 4 + 1] * kk.y + q[c * 4 + 2] * kk.z + q[c * 4 + 3] * kk.w; }
                    s += brow[j];
                    mx = fmaxf(mx, s);
                }
                float l = __builtin_amdgcn_exp2f(sk - mx);
                float o[64];
#pragma unroll
                for (int c = 0; c < 64; ++c) o[c] = 0.f;
                for (int j = jstart; j < nk; ++j) {
                    float s = 0.f; const LAS f32x4* kr = (const LAS f32x4*)(Ks + j * 64);
#pragma unroll
                    for (int c = 0; c < 16; ++c) { const f32x4 kk = kr[c]; s += q[c * 4] * kk.x + q[c * 4 + 1] * kk.y + q[c * 4 + 2] * kk.z + q[c * 4 + 3] * kk.w; }
                    s += brow[j];
                    const float p = __builtin_amdgcn_exp2f(s - mx);
                    l += p;
                    const LAS f32x4* vr = (const LAS f32x4*)(Vs + j * 64);
#pragma unroll
                    for (int c = 0; c < 16; ++c) { const f32x4 vv = vr[c]; o[c * 4] += p * vv.x; o[c * 4 + 1] += p * vv.y; o[c * 4 + 2] += p * vv.z; o[c * 4 + 3] += p * vv.w; }
                }
                const float rl = 1.0f / l;
#pragma unroll
                for (int c = 0; c < 8; ++c) {
                    const v4u gw4 = *(const v4u*)(GAB + row * 1024 + h16 * 64 + c * 8);
                    float r[8]; const unsigned gws[4] = {gw4.x, gw4.y, gw4.z, gw4.w};
#pragma unroll
                    for (int e = 0; e < 4; ++e) { r[2 * e] = o[c * 8 + 2 * e] * rl * sigmoidf_(bflo(gws[e])); r[2 * e + 1] = o[c * 8 + 2 * e + 1] * rl * sigmoidf_(bfhi(gws[e])); }
                    v4u w; w.x = pk2(r[0], r[1]); w.y = pk2(r[2], r[3]); w.z = pk2(r[4], r[5]); w.w = pk2(r[6], r[7]);
                    *(v4u*)(QB + row * 1024 + h16 * 64 + c * 8) = w;
                }
            }
        }
        if (BOTH(2)) GRID_BAR();
    }

    if (IN(3)) {
        {
            LAS float* scr = (LAS float*)(L + wave * 16384);
            constexpr int I_O = (D / 64) * (D / 32), I_GU = (D / 64) * (NGU / 32), I_DN = (DFF / 64) * (D / 32);
            for (int it = gw; it < I_O + I_GU + I_DN; it += NGW) {
                int r = it;
                if (r < I_O) { const int nblk = D / 32, kb = r / nblk, nb = r % nblk; transpose_item(w_out, D, D, WoutT, 64 * kb, 32 * nb, 32 * nb, scr, lane); continue; } r -= I_O;
                if (r < I_GU) { const int nblk = NGU / 32, kb = r / nblk, nb = r % nblk; const int n0 = 32 * nb;
                    const int src = ((n0 >> 7) & 1) * DFF + (n0 >> 8) * 128 + (n0 & 127);
                    transpose_item(w_gu, D, NGU, WguT, 64 * kb, src, n0, scr, lane); continue; } r -= I_GU;
                { const int nblk = D / 32, kb = r / nblk, nb = r % nblk; transpose_item(w_dn, DFF, D, WdnT, 64 * kb, 32 * nb, 32 * nb, scr, lane); }
            }
            __syncthreads();
        }
        if (vcu < 32) {
            const int gi = tid >> 7, e = tid & 127; const int seq = vcu * 4 + gi; const bool samp = seq >= 64; const int sb = (seq & 63) >> 3, h = seq & 7;
            const int ntok = samp ? 16 : SEQ; const size_t row0 = samp ? (size_t)(MP + sb * 16) : (size_t)sb * SEQ;
            LAS float* qs = (LAS float*)L + gi * 3200; LAS float* fs = qs + 1024; LAS float* ks = fs + 1024; LAS float* red = ks + 1024;
            float S[128];
#pragma unroll
            for (int d = 0; d < 128; ++d) S[d] = samp ? state_in[((size_t)(sb * 8 + h) * 128 + d) * 128 + e] : 0.f;
            const float lb = LBV[h * 128 + e], gn = hgrn_norm[e];
            const int col = h * 128 + e;
            for (int t0 = 0; t0 < ntok; t0 += 8) {
#pragma unroll
                for (int tt = 0; tt < 8; ++tt) { const size_t row = row0 + t0 + tt;
                    const float hq = bf2f(HQB[row * 1024 + col]), hf = bf2f(HFB[row * 1024 + col]);
                    const float f = lb + (1.0f - lb) * sigmoidf_(hf);
                    qs[tt * 128 + e] = hq; fs[tt * 128 + e] = f; ks[tt * 128 + e] = 1.0f - f; }
                LDS_WAIT(); __syncthreads();
                float o8[8];
#pragma unroll 1
                for (int tt = 0; tt < 8; ++tt) { const size_t row = row0 + t0 + tt;
                    const float v = bf2f(HIB[row * 1024 + col]); float o = 0.f;
#pragma unroll
                    for (int d4 = 0; d4 < 32; ++d4) { const f32x4 ff = *(const LAS f32x4*)(fs + tt * 128 + d4 * 4), kk = *(const LAS f32x4*)(ks + tt * 128 + d4 * 4), qq = *(const LAS f32x4*)(qs + tt * 128 + d4 * 4);
                        S[d4 * 4 + 0] = ff.x * S[d4 * 4 + 0] + kk.x * v; o += S[d4 * 4 + 0] * qq.x;
                        S[d4 * 4 + 1] = ff.y * S[d4 * 4 + 1] + kk.y * v; o += S[d4 * 4 + 1] * qq.y;
                        S[d4 * 4 + 2] = ff.z * S[d4 * 4 + 2] + kk.z * v; o += S[d4 * 4 + 2] * qq.z;
                        S[d4 * 4 + 3] = ff.w * S[d4 * 4 + 3] + kk.w * v; o += S[d4 * 4 + 3] * qq.w; }
                    const float ss = wave_sum(o * o);
                    if (lane == 0) red[tt * 2 + (wave & 1)] = ss;
#pragma unroll
                    for (int q8 = 0; q8 < 8; ++q8) if (q8 == tt) o8[q8] = o;
                }
                LDS_WAIT(); __syncthreads();
#pragma unroll
                for (int tt = 0; tt < 8; ++tt) { const size_t row = row0 + t0 + tt;
                    const float tot = red[tt * 2] + red[tt * 2 + 1]; const float rstd = 1.0f / sqrtf(tot * (1.0f / 128.0f) + RMS_EPS);
                    const float og = bf2f(HOGB[row * 1024 + col]), gh = bf2f(GHB[row * 1024 + col]);
                    const float val = o8[tt] * rstd * gn * (og * sigmoidf_(og));
                    const float ag = bf2f(QB[row * 1024 + col]);
                    QB[row * 1024 + col] = (bf16)f2bf(ag + sigmoidf_(gh) * val); }
            }
            float* so = out + (samp ? O_SS : O_SP) + (size_t)(sb * 8 + h) * 128 * 128;
#pragma unroll
            for (int d = 0; d < 128; ++d) so[(size_t)d * 128 + e] = S[d];
        }
        if (BOTH(3)) GRID_BAR();
    }

    if (IN(4)) {
        if (vcu < 32) skinny_item<0>(vcu, QB + (size_t)MP * 1024, WoutT, D, x_sample, Y1S, A2B + (size_t)MP * 1024, norm_ffn, ROWSQ + (size_t)MP * 4, nullptr, L, wave, lane);
        __syncthreads();
        pg8::Gemm g{QB, WoutT, MP, D, D}; pg8::StaticOrder S; S.init(MP, D, G, bx);
        pg8::EpiOut E{x_prompt, out, A2B, norm_ffn, ROWSQ};
        pg8::gemm_phase<pg8::EpiOut, pg8::StaticOrder, false, true>(L, g, S, E);
        if (BOTH(4)) GRID_BAR();
    }

    if (IN(5)) {
        pg8::Gemm g{A2B, WguT, MROWS, NGU, D}; pg8::StaticOrder S; S.init(MROWS, NGU, G, bx);
        pg8::EpiGU E{ACTB_, ROWSQ};
        pg8::gemm_phase<pg8::EpiGU, pg8::StaticOrder, true, true>(L, g, S, E);
        if (BOTH(5)) GRID_BAR();
    }

    if (IN(6)) {
        if (vcu < 32) skinny_item<1>(vcu, ACTB_ + (size_t)MP * DFF, WdnT, DFF, nullptr, Y1S, nullptr, nullptr, nullptr, out + O_YS, L, wave, lane);
        __syncthreads();
        pg8::Gemm g{ACTB_, WdnT, MP, D, DFF}; pg8::StaticOrder S; S.init(MP, D, G, bx);
        pg8::EpiDown E{out};
        pg8::gemm_phase<pg8::EpiDown, pg8::StaticOrder, false, true>(L, g, S, E);
        if (BOTH(6)) GRID_BAR();
    }

    if (IN(7)) {
        for (int m = gw; m < MP + MS; m += NGW) { float* r = (m < MP) ? out + (size_t)m * D : out + O_YS + (size_t)(m - MP) * D; rms_row_f32(r, norm_final, r, lane); }
    }
#undef IN
#undef BOTH
}

extern "C" void kernel_launch(void* const* d_in, const int* in_sizes, int n_in, void* d_out, int out_size, void* d_ws, size_t ws_size, hipStream_t stream) {
    if (n_in != 16 || ws_size < WS_END) { fprintf(stderr, "kernel_launch: unexpected n_in %d / ws_size %zu\n", n_in, ws_size); return; }
    (void)hipFuncSetAttribute((const void*)mk_fwd, hipFuncAttributeMaxDynamicSharedMemorySize, LDS_BYTES);
    const int grid = 256;
    (void)hipMemsetAsync((char*)d_ws + WS_CTL, 0, CTL_ZERO_BYTES, stream);
    Args a{};
    for (int i = 0; i < 16; ++i) a.in[i] = (const float*)d_in[i];
    a.out = (float*)d_out; a.ws = (unsigned char*)d_ws;
    if (N_LAUNCHES == 1) {
        a.ph_lo = 0; a.ph_hi = PER_PHASE; a.li = 0;
        hipLaunchKernelGGL(mk_fwd, dim3(grid), dim3(NWAVES * 64), LDS_BYTES, stream, a);
    } else {
        for (int li = 0; li < PER_PHASE; ++li) { a.ph_lo = li; a.ph_hi = li + 1; a.li = li;
            hipLaunchKernelGGL(mk_fwd, dim3(grid), dim3(NWAVES * 64), LDS_BYTES, stream, a); }
    }
}
```

```cpp
#include <hip/hip_runtime.h>
#include <cstdio>
#include <cstdint>

#ifndef MK_N_LAUNCHES
#define MK_N_LAUNCHES 1
#endif

constexpr int O_YP = 0, O_YS = 16777216, O_KP = 16908288, O_VP = 17039360, O_SP = 17170432, O_KS = 18219008, O_VS = 18350080, O_SS = 18481152;
namespace pg8 {
#define PG8_LAS __attribute__((address_space(3)))
typedef unsigned short bf16_t;
typedef short bf16x8 __attribute__((ext_vector_type(8)));
typedef float f32x4 __attribute__((ext_vector_type(4)));
typedef unsigned u32x4 __attribute__((ext_vector_type(4)));
constexpr int BM = 256, BK = 64, HALF = 128, HTB = HALF * BK * 2, STAGE_BYTES = 8 * HTB, NXCD = 8, WGM = 8;

__host__ __device__ __forceinline__ int lds_byte(int r, int c) { const int st = (r >> 4) * 2 + (c >> 5), rr = r & 15, cc = c & 31, ob = rr * 64 + cc * 2; return st * 1024 + (ob ^ (((ob >> 9) & 1) << 5)); }
__host__ __device__ __forceinline__ void stage_rc(int b, int& R, int& C) { const int st = b / 1024, sb = b % 1024, swz = sb ^ (((sb >> 9) & 1) << 5); R = (st >> 1) * 16 + swz / 64; C = (st & 1) * 32 + (swz % 64) / 2; }
__host__ __device__ __forceinline__ int perm32(int rho) { const int n = rho >> 4, i = rho & 15; return 8 * (i >> 2) + 4 * n + (i & 3); }

struct Unit { int pm, pn; };
struct Gemm { const bf16_t* A; const bf16_t* Bt; int M, N, K; };

struct StaticOrder {
    int nM, nN, nwg, G, c;
    __host__ __device__ void init(int M, int N, int G_, int c_) { nM = M / BM; nN = N / BM; nwg = nM * nN; G = G_; c = c_; }
    __host__ __device__ bool next(int i, Unit& u) const {
        const long L = (long)i * G + c; if (L >= nwg) return false;
        int wgid = (int)L; { const int q = nwg / NXCD, r = nwg % NXCD, xcd = wgid % NXCD, off = wgid / NXCD; wgid = (xcd < r ? xcd * (q + 1) : r * (q + 1) + (xcd - r) * q) + off; }
        const int nig = WGM * nN, gid = wgid / nig, fm = gid * WGM, gsz = (nM - fm) < WGM ? (nM - fm) : WGM;
        u.pm = fm + ((wgid % nig) % gsz); u.pn = (wgid % nig) / gsz; return true;
    }
    __device__ __forceinline__ void a_ready(const Unit&) const {}
    __device__ __forceinline__ void done(const Unit&) const {}
};

__device__ __forceinline__ unsigned cvt_pk_bf16(float lo, float hi) { unsigned r; asm volatile("v_cvt_pk_bf16_f32 %0, %1, %2" : "=v"(r) : "v"(lo), "v"(hi)); return r; }


template <int CTRL> __device__ __forceinline__ float dpp0(float v) { return __builtin_bit_cast(float, __builtin_amdgcn_update_dpp(0, __builtin_bit_cast(int, v), CTRL, 0xf, 0xf, true)); }
__device__ __forceinline__ float row_scan16(float v) { v += dpp0<0x111>(v); v += dpp0<0x112>(v); v += dpp0<0x114>(v); v += dpp0<0x118>(v); return v; }
struct EpiProj {
    static constexpr bool PERM = true, AFTER_DRAIN = false;
    bf16_t* Q; bf16_t* KV; bf16_t* H0; size_t hstride; float* out; float qscale;
    bf16_t* QE; bf16_t* QE2; bf16_t* KLP; bf16_t* KLS; float* EBL; const float* lbv;
    __device__ __forceinline__ void gate_tile(const f32x4 (&acc)[2][2][4][2], const Unit& u, int wr, int wc, int fr, int fq) const {
        const int lane = fq * 16 + fr;
        const int colb = (u.pn - 5) * 128 + wc * 32 + 8 * fq;
        const bool samp = (u.pm == 64);
#pragma unroll
        for (int ai = 0; ai < 2; ++ai) {
#pragma unroll
            for (int n = 0; n < 2; ++n) {
                const f32x4 lb = *(const f32x4*)(lbv + colb + 4 * n);
                float gs[4][4], ff[4][4], tot[4][4];
#pragma unroll
                for (int m = 0; m < 4; ++m)
#pragma unroll
                    for (int i = 0; i < 4; ++i) {
                        const float hf = acc[ai][1][m][n][i];
                        const float sg = __builtin_amdgcn_rcpf(1.0f + __builtin_amdgcn_exp2f(-1.4426950408889634f * hf));
                        const float f = lb[i] + (1.0f - lb[i]) * sg;
                        ff[m][i] = f;
                        const float g = __builtin_amdgcn_logf(f) * 0.6931471805599453f;
                        const float sc = row_scan16(g);
                        gs[m][i] = sc;
                        tot[m][i] = __shfl(sc, lane | 15, 64);
                    }
                float bl[4][4];
#pragma unroll
                for (int i = 0; i < 4; ++i) {
                    if (!samp) {
                        float pre = 0.f;
#pragma unroll
                        for (int m = 0; m < 4; ++m) { gs[m][i] += pre; pre += tot[m][i]; }
#pragma unroll
                        for (int m = 0; m < 4; ++m) bl[m][i] = pre;
                    } else {
#pragma unroll
                        for (int m = 0; m < 4; ++m) bl[m][i] = tot[m][i];
                    }
                }
#pragma unroll
                for (int m = 0; m < 4; ++m) {
                    const int row = u.pm * BM + ai * HALF + wr * 64 + m * 16 + fr;
                    float qe[4], q2[4], kl[4];
#pragma unroll
                    for (int i = 0; i < 4; ++i) {
                        const float q = acc[ai][0][m][n][i], b = gs[m][i], d = bl[m][i] - b;
                        qe[i] = q * __builtin_amdgcn_exp2f(1.4426950408889634f * b);
                        q2[i] = q * __builtin_amdgcn_exp2f(-1.4426950408889634f * d);
                        kl[i] = (1.0f - ff[m][i]) * __builtin_amdgcn_exp2f(1.4426950408889634f * d);
                    }
                    const size_t o = (size_t)row * 1024 + colb + 4 * n;
                    uint2 w;
                    w.x = cvt_pk_bf16(qe[0], qe[1]); w.y = cvt_pk_bf16(qe[2], qe[3]); *(uint2*)(QE + o) = w;
                    w.x = cvt_pk_bf16(q2[0], q2[1]); w.y = cvt_pk_bf16(q2[2], q2[3]); *(uint2*)(QE2 + o) = w;
                    w.x = cvt_pk_bf16(kl[0], kl[1]); w.y = cvt_pk_bf16(kl[2], kl[3]);
                    if (row < 16384) *(uint2*)(KLP + o) = w; else *(uint2*)(KLS + (size_t)(row - 16384) * 1024 + colb + 4 * n) = w;
                }
                if (fr == 0) {
                    if (!samp) {
                        const int ci = u.pm * 4 + ai * 2 + wr;
                        f32x4 e;
#pragma unroll
                        for (int i = 0; i < 4; ++i) e[i] = __builtin_amdgcn_exp2f(1.4426950408889634f * bl[0][i]);
                        *(f32x4*)(EBL + (size_t)ci * 1024 + colb + 4 * n) = e;
                    } else if (ai == 0) {
#pragma unroll
                        for (int m = 0; m < 4; ++m) { f32x4 e;
#pragma unroll
                            for (int i = 0; i < 4; ++i) e[i] = __builtin_amdgcn_exp2f(1.4426950408889634f * bl[m][i]);
                            *(f32x4*)(EBL + (size_t)(256 + wr * 4 + m) * 1024 + colb + 4 * n) = e; }
                    }
                }
            }
        }
    }
    __device__ __forceinline__ void operator()(const f32x4 (&acc)[2][2][4][2], const Unit& u, int wr, int wc, int fr, int fq) const {
        if (u.pn >= 5 && u.pn <= 12) { gate_tile(acc, u, wr, wc, fr, fq); return; }
        const int row0 = u.pm * BM + wr * 64 + fr;
        bf16_t* base; int ldc, c0; float sc = 1.f;
        if (u.pn < 4) { base = Q; ldc = 1024; c0 = u.pn * 256; sc = qscale; }
        else if (u.pn == 4) { base = KV; ldc = 256; c0 = 0; }
        else { const int t = (u.pn - 5) >> 2; base = H0 + (size_t)t * hstride; ldc = 1024; c0 = ((u.pn - 5) & 3) * 256; }
        const int col0 = c0 + wc * 32 + 8 * fq;
#pragma unroll
        for (int ai = 0; ai < 2; ++ai)
#pragma unroll
            for (int m = 0; m < 4; ++m) {
                const int row = row0 + ai * HALF + m * 16;
                bf16_t* rowp = base + (size_t)row * ldc + col0;
#pragma unroll
                for (int bj = 0; bj < 2; ++bj) {
                    const f32x4 v0 = acc[ai][bj][m][0] * sc, v1 = acc[ai][bj][m][1] * sc;
                    u32x4 w; w.x = cvt_pk_bf16(v0[0], v0[1]); w.y = cvt_pk_bf16(v0[2], v0[3]); w.z = cvt_pk_bf16(v1[0], v1[1]); w.w = cvt_pk_bf16(v1[2], v1[3]);
                    *(u32x4*)(rowp + bj * HALF) = w;
                }
                if (u.pn == 4) {
                    int orow = -1; int okb = 0, ovb = 0;
                    if (row < 16384) { const int t = row & 2047; if (t >= 1920) { orow = (row >> 11) * 128 + (t - 1920); okb = O_KP; ovb = O_VP; } }
                    else if (row < 16512) { const int rs = row - 16384; orow = (rs >> 4) * 128 + 112 + (rs & 15); okb = O_KS; ovb = O_VS; }
                    if (orow >= 0) {
                        float* kd = out + okb + (size_t)orow * 128 + wc * 32 + 8 * fq;
                        float* vd = out + ovb + (size_t)orow * 128 + wc * 32 + 8 * fq;
                        *(f32x4*)(kd) = acc[ai][0][m][0]; *(f32x4*)(kd + 4) = acc[ai][0][m][1];
                        *(f32x4*)(vd) = acc[ai][1][m][0]; *(f32x4*)(vd + 4) = acc[ai][1][m][1];
                    }
                }
            }
    }
};

struct EpiOut {
    static constexpr bool PERM = true, AFTER_DRAIN = true;
    const float* x; float* Y1; bf16_t* A2; const float* nw; float* rowsq;
    __device__ __forceinline__ void fused(f32x4 (&acc)[2][2][4][2], const Unit& u, int wr, int wc, int fr, int fq, PG8_LAS unsigned char* lds, int wid, int lane) const {
        PG8_LAS float* P = (PG8_LAS float*)lds;
        const int col0 = u.pn * BM + wc * 32 + 8 * fq;
        f32x4 nwv[2][2];
#pragma unroll
        for (int bj = 0; bj < 2; ++bj)
#pragma unroll
            for (int n = 0; n < 2; ++n) nwv[bj][n] = *(const f32x4*)(nw + col0 + bj * HALF + 4 * n);
#pragma unroll
        for (int ai = 0; ai < 2; ++ai)
#pragma unroll
            for (int m = 0; m < 4; ++m) {
                const int rl = ai * HALF + wr * 64 + m * 16 + fr; const size_t off = (size_t)(u.pm * BM + rl) * 1024 + col0;
                float s = 0.f;
#pragma unroll
                for (int bj = 0; bj < 2; ++bj) {
                    const f32x4 xa = *(const f32x4*)(x + off + bj * HALF), xb = *(const f32x4*)(x + off + bj * HALF + 4);
                    const f32x4 y0 = acc[ai][bj][m][0] + xa, y1 = acc[ai][bj][m][1] + xb;
                    *(f32x4*)(Y1 + off + bj * HALF) = y0; *(f32x4*)(Y1 + off + bj * HALF + 4) = y1;
                    s += (y0[0] * y0[0] + y0[1] * y0[1]) + (y0[2] * y0[2] + y0[3] * y0[3]) + (y1[0] * y1[0] + y1[1] * y1[1]) + (y1[2] * y1[2] + y1[3] * y1[3]);
                    const f32x4 a0 = y0 * nwv[bj][0], a1 = y1 * nwv[bj][1];
                    u32x4 w; w.x = cvt_pk_bf16(a0[0], a0[1]); w.y = cvt_pk_bf16(a0[2], a0[3]); w.z = cvt_pk_bf16(a1[0], a1[1]); w.w = cvt_pk_bf16(a1[2], a1[3]);
                    *(u32x4*)(A2 + off + bj * HALF) = w;
                }
                s += __shfl_xor(s, 16); s += __shfl_xor(s, 32);
                if (fq == 0) P[rl * 4 + wc] = s;
                asm volatile("" ::: "memory");
            }
        asm volatile("s_waitcnt lgkmcnt(0)" ::: "memory"); __builtin_amdgcn_s_barrier(); asm volatile("" ::: "memory");
        const int tid = wid * 64 + lane;
        if (tid < 256) { const float t = (P[tid * 4 + 0] + P[tid * 4 + 1]) + (P[tid * 4 + 2] + P[tid * 4 + 3]); rowsq[(size_t)(u.pm * BM + tid) * 4 + u.pn] = t; }
        asm volatile("s_waitcnt lgkmcnt(0)" ::: "memory"); __builtin_amdgcn_s_barrier(); asm volatile("" ::: "memory");
    }
};

struct EpiGU {
    static constexpr bool PERM = true, AFTER_DRAIN = false;
    bf16_t* ACT; const float* rowsq;
    __device__ __forceinline__ void operator()(const f32x4 (&acc)[2][2][4][2], const Unit& u, int wr, int wc, int fr, int fq) const {
        const int row0 = u.pm * BM + wr * 64 + fr, col0 = u.pn * HALF + wc * 32 + 8 * fq;
#pragma unroll
        for (int ai = 0; ai < 2; ++ai)
#pragma unroll
            for (int m = 0; m < 4; ++m) {
                const int row = row0 + ai * HALF + m * 16;
                const f32x4 p = *(const f32x4*)(rowsq + (size_t)row * 4);
                const float rstd = 1.0f / sqrtf(((p[0] + p[1]) + (p[2] + p[3])) * (1.0f / 1024.0f) + 1e-6f);
                float r[8];
#pragma unroll
                for (int n = 0; n < 2; ++n)
#pragma unroll
                    for (int i = 0; i < 4; ++i) {
                        const float g = acc[ai][0][m][n][i] * rstd, uu = acc[ai][1][m][n][i] * rstd;
                        const float sg = __builtin_amdgcn_rcpf(1.0f + __builtin_amdgcn_exp2f(-1.4426950408889634f * g));
                        r[n * 4 + i] = g * sg * uu;
                    }
                u32x4 w; w.x = cvt_pk_bf16(r[0], r[1]); w.y = cvt_pk_bf16(r[2], r[3]); w.z = cvt_pk_bf16(r[4], r[5]); w.w = cvt_pk_bf16(r[6], r[7]);
                *(u32x4*)(ACT + (size_t)row * 2816 + col0) = w;
            }
    }
};

struct EpiDown {
    static constexpr bool PERM = false, AFTER_DRAIN = false;
    float* Y;
    __device__ __forceinline__ void operator()(const f32x4 (&acc)[2][2][4][2], const Unit& u, int wr, int wc, int fr, int fq) const {
        const int row0 = u.pm * BM + wr * 64 + fr, col0 = u.pn * BM + wc * 32 + 4 * fq;
#pragma unroll
        for (int ai = 0; ai < 2; ++ai)
#pragma unroll
            for (int m = 0; m < 4; ++m) { float* rowp = Y + (size_t)(row0 + ai * HALF + m * 16) * 1024 + col0;
#pragma unroll
                for (int bj = 0; bj < 2; ++bj)
#pragma unroll
                    for (int n = 0; n < 2; ++n) { const f32x4 b = *(const f32x4*)(rowp + bj * HALF + n * 16); *(f32x4*)(rowp + bj * HALF + n * 16) = acc[ai][bj][m][n] + b; }
                if (m & 1) asm volatile("" ::: "memory"); }
    }
};

template <class Epi, class Sched, bool ALIGN_EPI = false, bool SP2 = false>
__device__ __forceinline__ void gemm_phase(PG8_LAS unsigned char* lds, const Gemm g, const Sched& S, const Epi& E) {
    const int tid = threadIdx.x, wid = __builtin_amdgcn_readfirstlane(tid >> 6), lane = tid & 63, wr = wid >> 2, wc = wid & 3, fr = lane & 15, fq = lane >> 4;
    const int K = g.K, nt = K / BK;
    unsigned voffA[2], voffB[2];
#pragma unroll
    for (int i = 0; i < 2; ++i) { int R, C; stage_rc(tid * 16 + i * 8192, R, C); const int Rb = Epi::PERM ? ((R & ~31) + perm32(R & 31)) : R;
        voffA[i] = (unsigned)(R * K + C) * 2u; voffB[i] = (unsigned)(Rb * K + C) * 2u; }
    const size_t kstep = (size_t)(BK * 2);
    const size_t hstep = (size_t)HALF * K * 2;
    const size_t tstep = 2 * hstep;
    const unsigned ldsw = (unsigned)wid * 1024u;
    const int aoff = lds_byte(wr * 64 + fr, fq * 8), boff = lds_byte(wc * 32 + fr, fq * 8);
#define PG8_SA(b, h) (((b) * 2 + (h)) * HTB)
#define PG8_SB(b, h) ((4 + (b) * 2 + (h)) * HTB)
#define PG8_STAGE(bufoff, gbase, voff) do { _Pragma("unroll") for (int _i = 0; _i < 2; ++_i) \
        __builtin_amdgcn_global_load_lds((const unsigned*)((const char*)(gbase) + (voff)[_i]), (PG8_LAS unsigned*)(lds + (bufoff) + ldsw + _i * 8192), 16, 0, 0); } while (0)
#define PG8_LDA(dst, b, h) do { _Pragma("unroll") for (int m = 0; m < 4; ++m) _Pragma("unroll") for (int k = 0; k < 2; ++k) dst[m][k] = *(const PG8_LAS bf16x8*)(lds + PG8_SA(b, h) + aoff + m * 2048 + k * 1024); } while (0)
#define PG8_LDB(dst, b, h) do { _Pragma("unroll") for (int n = 0; n < 2; ++n) _Pragma("unroll") for (int k = 0; k < 2; ++k) dst[n][k] = *(const PG8_LAS bf16x8*)(lds + PG8_SB(b, h) + boff + n * 2048 + k * 1024); } while (0)
#define PG8_MMA(ai, bj, At, Bt) do { __builtin_amdgcn_s_setprio(1); _Pragma("unroll") for (int m = 0; m < 4; ++m) _Pragma("unroll") for (int n = 0; n < 2; ++n) _Pragma("unroll") for (int k = 0; k < 2; ++k) \
        acc[ai][bj][m][n] = __builtin_amdgcn_mfma_f32_16x16x32_bf16(Bt[n][k], At[m][k], acc[ai][bj][m][n], 0, 0, 0); __builtin_amdgcn_s_setprio(0); } while (0)
#define PG8_WAIT_V(n) asm volatile("s_waitcnt vmcnt(" #n ")" ::: "memory")
#define PG8_WAIT_L(n) asm volatile("s_waitcnt lgkmcnt(" #n ")" ::: "memory")
#define PG8_BAR __builtin_amdgcn_s_barrier()
#define PG8_SCHED __builtin_amdgcn_sched_barrier(0)
    Unit cur, nxt; int ui = 0;
    if (!S.next(0, cur)) return;
    f32x4 acc[2][2][4][2];
#pragma unroll
    for (int a = 0; a < 2; ++a)
#pragma unroll
        for (int b = 0; b < 2; ++b)
#pragma unroll
            for (int m = 0; m < 4; ++m)
#pragma unroll
                for (int n = 0; n < 2; ++n) acc[a][b][m][n] = (f32x4){0.f, 0.f, 0.f, 0.f};
    bf16x8 At[4][2], B0[2][2], B1[2][2];
    const char* cA = (const char*)g.A + (size_t)cur.pm * tstep; const char* cB = (const char*)g.Bt + (size_t)cur.pn * tstep;
    S.a_ready(cur);
    if constexpr (SP2) {
        PG8_STAGE(PG8_SB(0, 0), cB, voffB); PG8_STAGE(PG8_SB(0, 1), cB + hstep, voffB); PG8_STAGE(PG8_SA(0, 0), cA, voffA); PG8_STAGE(PG8_SA(0, 1), cA + hstep, voffA);
        if (wr == 1) PG8_BAR;
        PG8_WAIT_V(2); PG8_BAR;
        PG8_STAGE(PG8_SB(1, 0), cB + kstep, voffB); PG8_STAGE(PG8_SA(1, 0), cA + kstep, voffA); PG8_STAGE(PG8_SB(1, 1), cB + hstep + kstep, voffB);
        PG8_WAIT_V(6); PG8_BAR;
    } else {
        PG8_STAGE(PG8_SB(0, 0), cB, voffB); PG8_STAGE(PG8_SA(0, 0), cA, voffA); PG8_STAGE(PG8_SB(0, 1), cB + hstep, voffB); PG8_STAGE(PG8_SA(0, 1), cA + hstep, voffA);
        if (wr == 1) PG8_BAR;
        PG8_WAIT_V(4); PG8_BAR;
        PG8_STAGE(PG8_SB(1, 0), cB + kstep, voffB); PG8_STAGE(PG8_SA(1, 0), cA + kstep, voffA); PG8_STAGE(PG8_SB(1, 1), cB + hstep + kstep, voffB);
        PG8_WAIT_V(6); PG8_BAR;
    }
    for (;;) {
        const bool has_next = S.next(ui + 1, nxt);
        const char* nA = has_next ? (const char*)g.A + (size_t)nxt.pm * tstep : cA; const char* nB = has_next ? (const char*)g.Bt + (size_t)nxt.pn * tstep : cB;
        for (int t = 0; t < nt; t += 2) {
            const bool last = (t == nt - 2);
            const char* a1 = cA + (size_t)(t + 1) * kstep;
            const char* a2 = last ? nA : cA + (size_t)(t + 2) * kstep; const char* b2 = last ? nB : cB + (size_t)(t + 2) * kstep;
            const char* a3 = a2 + kstep; const char* b3 = b2 + kstep;
            if (last && has_next) S.a_ready(nxt);
            if constexpr (SP2) {
            PG8_LDB(B0, 0, 0); PG8_LDB(B1, 0, 1); PG8_SCHED; PG8_LDA(At, 0, 0); PG8_STAGE(PG8_SA(1, 1), a1 + hstep, voffA);
            PG8_WAIT_V(8); PG8_WAIT_L(0); PG8_BAR; PG8_MMA(0, 0, At, B0); PG8_MMA(0, 1, At, B1); PG8_BAR; PG8_SCHED;
            PG8_LDA(At, 0, 1); PG8_STAGE(PG8_SB(0, 0), b2, voffB); PG8_STAGE(PG8_SB(0, 1), b2 + hstep, voffB); PG8_STAGE(PG8_SA(0, 0), a2, voffA);
            PG8_WAIT_V(8); PG8_WAIT_L(0); PG8_BAR; PG8_MMA(1, 0, At, B0); PG8_MMA(1, 1, At, B1); PG8_BAR; PG8_SCHED;
            PG8_LDB(B0, 1, 0); PG8_LDB(B1, 1, 1); PG8_SCHED; PG8_LDA(At, 1, 0); PG8_STAGE(PG8_SA(0, 1), a2 + hstep, voffA);
            PG8_WAIT_V(8); PG8_WAIT_L(0); PG8_BAR; PG8_MMA(0, 0, At, B0); PG8_MMA(0, 1, At, B1); PG8_BAR; PG8_SCHED;
            PG8_LDA(At, 1, 1); PG8_STAGE(PG8_SB(1, 0), b3, voffB); PG8_STAGE(PG8_SB(1, 1), b3 + hstep, voffB); PG8_STAGE(PG8_SA(1, 0), a3, voffA);
            PG8_WAIT_V(8); PG8_WAIT_L(0); PG8_BAR; PG8_MMA(1, 0, At, B0); PG8_MMA(1, 1, At, B1); PG8_BAR; PG8_SCHED;
            } else {
            PG8_LDB(B0, 0, 0); PG8_SCHED; PG8_LDA(At, 0, 0); PG8_STAGE(PG8_SA(1, 1), a1 + hstep, voffA);
            PG8_WAIT_L(8); PG8_BAR; PG8_WAIT_L(0); PG8_MMA(0, 0, At, B0); PG8_BAR; PG8_SCHED;
            PG8_LDB(B1, 0, 1); PG8_STAGE(PG8_SB(0, 0), b2, voffB);
            PG8_BAR; PG8_WAIT_L(0); PG8_MMA(0, 1, At, B1); PG8_BAR;
            PG8_LDA(At, 0, 1); PG8_STAGE(PG8_SA(0, 0), a2, voffA);
            PG8_BAR; PG8_WAIT_L(0); PG8_MMA(1, 0, At, B0); PG8_BAR; PG8_SCHED;
            PG8_STAGE(PG8_SB(0, 1), b2 + hstep, voffB);
            PG8_WAIT_V(6); PG8_BAR; PG8_MMA(1, 1, At, B1); PG8_BAR;
            PG8_LDB(B0, 1, 0); PG8_SCHED; PG8_LDA(At, 1, 0); PG8_STAGE(PG8_SA(0, 1), a2 + hstep, voffA);
            PG8_WAIT_L(8); PG8_BAR; PG8_WAIT_L(0); PG8_MMA(0, 0, At, B0); PG8_BAR; PG8_SCHED;
            PG8_LDB(B1, 1, 1); PG8_STAGE(PG8_SB(1, 0), b3, voffB);
            PG8_BAR; PG8_WAIT_L(0); PG8_MMA(0, 1, At, B1); PG8_BAR;
            PG8_LDA(At, 1, 1); PG8_STAGE(PG8_SA(1, 0), a3, voffA);
            PG8_BAR; PG8_WAIT_L(0); PG8_MMA(1, 0, At, B0); PG8_BAR; PG8_SCHED;
            PG8_STAGE(PG8_SB(1, 1), b3 + hstep, voffB);
            PG8_WAIT_V(6); PG8_BAR; PG8_MMA(1, 1, At, B1); PG8_BAR;
            }
        }
        if constexpr (ALIGN_EPI) { if (wr == 0) PG8_BAR; }
        if constexpr (!Epi::AFTER_DRAIN) { E(acc, cur, wr, wc, fr, fq); S.done(cur); }
        if (!has_next) break;
#pragma unroll
        for (int a = 0; a < 2; ++a)
#pragma unroll
            for (int b = 0; b < 2; ++b)
#pragma unroll
                for (int m = 0; m < 4; ++m)
#pragma unroll
                    for (int n = 0; n < 2; ++n) acc[a][b][m][n] = (f32x4){0.f, 0.f, 0.f, 0.f};
        cur = nxt; cA = nA; cB = nB; ++ui;
        if constexpr (ALIGN_EPI) { if (wr == 1) PG8_BAR; }
    }
    PG8_WAIT_V(0);
    if constexpr (!ALIGN_EPI) { if (wr == 0) PG8_BAR; }
    PG8_BAR;
    if constexpr (Epi::AFTER_DRAIN) { E.fused(acc, cur, wr, wc, fr, fq, lds, wid, lane); S.done(cur); }
#undef PG8_SA
#undef PG8_SB
#undef PG8_STAGE
#undef PG8_LDA
#undef PG8_LDB
#undef PG8_MMA
#undef PG8_WAIT_V
#undef PG8_WAIT_L
#undef PG8_BAR
#undef PG8_SCHED
}
}

constexpr int NWAVES = 8;
constexpr int N_LAUNCHES = MK_N_LAUNCHES;
constexpr int PER_PHASE = 8;
constexpr int D = 1024, NBATCH = 8, SEQ = 2048, MP = NBATCH * SEQ, MS = 128, MROWS = 16640;
constexpr int NIN = 7424, DFF = 2816, NGU = 5632;
constexpr float RMS_EPS = 1e-6f;
constexpr float LOG2E = 1.4426950408889634f;
constexpr float C2 = 0.125f * LOG2E;

constexpr size_t MiB = 1u << 20;
constexpr size_t ACTB = (size_t)MROWS * 1024 * 2;
constexpr size_t WS_CTL = 0, CTL_ZERO_BYTES = 1 * MiB;
constexpr size_t WS_WIN = 1 * MiB;
constexpr size_t WS_Q = 16 * MiB;
constexpr size_t WS_KV = WS_Q + ACTB;
constexpr size_t WS_HQ = WS_KV + 8 * MiB + MiB / 2;
constexpr size_t WS_HF = WS_HQ + ACTB, WS_HI = WS_HF + ACTB, WS_HOG = WS_HI + ACTB, WS_GA = WS_HOG + ACTB, WS_GH = WS_GA + ACTB;
constexpr size_t WS_MISC = WS_GH + ACTB;
constexpr size_t WS_A2 = WS_HQ;
constexpr size_t WS_ACT = WS_HF;
constexpr size_t WS_WOUT = WS_GA;
constexpr size_t WS_WGU = WS_WOUT + 2 * MiB, WS_WDN = WS_WGU + 11 * MiB;
static_assert(WS_WDN + (size_t)1024 * 2816 * 2 <= WS_GH, "late weights inside GA");
static_assert(WS_ACT + (size_t)MROWS * DFF * 2 <= WS_GA, "ACT inside HF..HOG");
constexpr size_t WS_BIAS = WS_MISC;
constexpr size_t WS_SINK = WS_BIAS + 16 * 256 * 4;
constexpr size_t WS_LB = WS_SINK + 256;
constexpr size_t WS_ROWSQ = WS_MISC + 64 * 1024;
constexpr size_t WS_Y1S = WS_MISC + 512 * 1024;
constexpr size_t WS_KLS = WS_MISC + 1 * MiB;
constexpr size_t WS_EBL = WS_MISC + 1 * MiB + 512 * 1024;
constexpr size_t WS_END = WS_MISC + 3 * MiB;
static_assert(ACTB + (size_t)16384 * 1024 * 2 <= (size_t)O_KP * 4, "KLP inside d_out's y_prompt + y_sample region");
static_assert(WS_END <= 256 * MiB, "d_ws map");

constexpr int CW_TMO = 0, CW_CODE = 1, CW_BAR = 4096;

constexpr int LDS_BYTES = 147456;
constexpr int LDSCTL_OFF = LDS_BYTES - 512, MISC_OFF = LDSCTL_OFF + 320;

#define GAS __attribute__((address_space(1)))
#define LAS __attribute__((address_space(3)))
typedef unsigned short bf16;
typedef unsigned v4u __attribute__((ext_vector_type(4)));
typedef float f32x4 __attribute__((ext_vector_type(4)));
typedef short bf16x8 __attribute__((ext_vector_type(8)));
typedef GAS unsigned gu32;
#define RLX_AGENT __ATOMIC_RELAXED, __HIP_MEMORY_SCOPE_AGENT
#define LDS_WAIT() asm volatile("s_waitcnt lgkmcnt(0)" ::: "memory")
#define VM_WAIT() asm volatile("s_waitcnt vmcnt(0)" ::: "memory")
__device__ __forceinline__ unsigned f2bf(float f) { unsigned u = __builtin_bit_cast(unsigned, f); return (u + 0x7fffu + ((u >> 16) & 1u)) >> 16; }
__device__ __forceinline__ unsigned pk2(float lo, float hi) { return f2bf(lo) | (f2bf(hi) << 16); }
__device__ __forceinline__ float bf2f(unsigned short h) { return __builtin_bit_cast(float, (unsigned)h << 16); }
__device__ __forceinline__ float bflo(unsigned w) { return __builtin_bit_cast(float, w << 16); }
__device__ __forceinline__ float bfhi(unsigned w) { return __builtin_bit_cast(float, w & 0xffff0000u); }
__device__ __forceinline__ float sigmoidf_(float v) { return 1.0f / (1.0f + __expf(-v)); }

#define XB_TMO      128
#define XB_XCNT(j)  (256  + 64 * (j))
#define XB_XSUB(j)  (1280 + 64 * (j))
#define XB_XGEN(j)  (2304 + 64 * (j))
#define XB_TOP      3328
#define XB_TOPGEN   3392
#define XCD_BAR_WORDS 3456
#define XB_SPIN_CAP (1u << 18)
__device__ __forceinline__ unsigned xb_ld(unsigned* p)              { return __hip_atomic_load(p, __ATOMIC_RELAXED, __HIP_MEMORY_SCOPE_AGENT); }
__device__ __forceinline__ unsigned xb_add(unsigned* p, unsigned v) { return __hip_atomic_fetch_add(p, v, __ATOMIC_RELAXED, __HIP_MEMORY_SCOPE_AGENT); }
__device__ __forceinline__ unsigned xb_xcc_id() { return (unsigned)__builtin_amdgcn_s_getreg((3 << 11) | 20) & 0xFu; }
#define XB_SPIN(cond, bar) do { unsigned _sp = 0; while (cond) { __builtin_amdgcn_s_sleep(1); \
    if ((++_sp & 255u) == 0u) { if (xb_ld(&(bar)[XB_TMO])) break; if (_sp > XB_SPIN_CAP) { atomicAdd(&(bar)[XB_TMO], 1u); break; } } } } while (0)
struct XcdBarrier { unsigned* bar; unsigned x; volatile LAS unsigned* st; };
__device__ __forceinline__ XcdBarrier xcd_barrier_post(unsigned* bar, volatile LAS unsigned* st) {
    XcdBarrier b; b.bar = bar; b.x = xb_xcc_id(); b.st = st;
    if (threadIdx.x == 0) (void)xb_add(&bar[XB_XCNT(b.x)], 1u);
    return b;
}
__device__ __forceinline__ void xcd_barrier_complete(unsigned* bar, unsigned x, unsigned& nloc, unsigned& nx) {
    const unsigned G = gridDim.x * gridDim.y * gridDim.z;
    unsigned sum, cnt, mine, sp = 0u;
    for (;;) {
        sum = 0u; cnt = 0u; mine = 0u;
#pragma unroll
        for (unsigned j = 0; j < 16; ++j) { const unsigned c = xb_ld(&bar[XB_XCNT(j)]); sum += c; cnt += (c > 0u) ? 1u : 0u; mine = (j == x) ? c : mine; }
        if (sum == G) break;
        __builtin_amdgcn_s_sleep(1);
        if ((++sp & 255u) == 0u) { if (xb_ld(&bar[XB_TMO])) break; if (sp > XB_SPIN_CAP) { atomicAdd(&bar[XB_TMO], 1u); break; } }
    }
    nloc = mine > 0u ? mine : 1u; nx = cnt > 0u ? cnt : 1u;
}
__device__ __forceinline__ void xcd_barrier(const XcdBarrier& b) {
    asm volatile("s_waitcnt vmcnt(0)" ::: "memory");
    __syncthreads();
    if (threadIdx.x == 0) {
        unsigned* bar = b.bar;
        __builtin_amdgcn_s_waitcnt(0);
        unsigned nloc = b.st[0], nx = b.st[1];
        if (nloc == 0u) { xcd_barrier_complete(bar, b.x, nloc, nx); b.st[0] = nloc; b.st[1] = nx; }
        const unsigned old = xb_add(&bar[XB_XSUB(b.x)], 1u);
        const unsigned gen = old / nloc;
        if (old + 1u == (gen + 1u) * nloc) {
            __builtin_amdgcn_fence(__ATOMIC_RELEASE, "agent");
            asm volatile("s_waitcnt vmcnt(0)" ::: "memory");
            const unsigned og = xb_add(&bar[XB_TOP], 1u);
            const unsigned tg = og / nx;
            if (og + 1u == (tg + 1u) * nx) xb_add(&bar[XB_TOPGEN], 1u);
            else XB_SPIN(xb_ld(&bar[XB_TOPGEN]) == tg, bar);
            __builtin_amdgcn_fence(__ATOMIC_ACQUIRE, "agent");
            xb_add(&bar[XB_XGEN(b.x)], 1u);
            asm volatile("s_waitcnt vmcnt(0)" ::: "memory");
        } else {
            XB_SPIN(xb_ld(&bar[XB_XGEN(b.x)]) == gen, bar);
            __builtin_amdgcn_fence(__ATOMIC_ACQUIRE, "agent");
            asm volatile("s_waitcnt vmcnt(0)" ::: "memory");
        }
    }
    __syncthreads();
}

__device__ __forceinline__ float wave_sum(float v) {
#pragma unroll
    for (int o = 1; o < 64; o <<= 1) v += __shfl_xor(v, o);
    return v;
}
__device__ __forceinline__ void transpose_item(const float* W, int K, int N, bf16* WT, int k0, int src_n0, int dst_n0, LAS float* scr, int lane) {
#pragma unroll 8
    for (int i = 0; i < 32; ++i) { const int kk = 2 * i + (lane >> 5); scr[kk * 33 + (lane & 31)] = W[(size_t)(k0 + kk) * N + src_n0 + (lane & 31)]; }
    LDS_WAIT(); asm volatile("" ::: "memory");
    const int c = lane & 7;
#pragma unroll
    for (int j = 0; j < 4; ++j) { const int n = (lane >> 3) + 8 * j; const LAS float* s = scr + (8 * c) * 33 + n;
        v4u o; o.x = pk2(s[0 * 33], s[1 * 33]); o.y = pk2(s[2 * 33], s[3 * 33]); o.z = pk2(s[4 * 33], s[5 * 33]); o.w = pk2(s[6 * 33], s[7 * 33]);
        *(GAS v4u*)(WT + (size_t)(dst_n0 + n) * K + k0 + 8 * c) = o; }
    LDS_WAIT(); asm volatile("" ::: "memory");
}
__device__ __forceinline__ void rms_row_to_bf16(const float* xrow, const float* nw, bf16* orow, int lane) {
    const GAS f32x4* xr = (const GAS f32x4*)xrow + lane; const GAS f32x4* wr4 = (const GAS f32x4*)nw + lane;
    f32x4 v[4]; float s = 0.f;
#pragma unroll
    for (int j = 0; j < 4; ++j) { v[j] = xr[64 * j]; s += (v[j].x * v[j].x + v[j].y * v[j].y) + (v[j].z * v[j].z + v[j].w * v[j].w); }
    const float rstd = 1.f / sqrtf(wave_sum(s) * (1.f / D) + RMS_EPS);
    GAS unsigned long long* o8 = (GAS unsigned long long*)orow + lane;
#pragma unroll
    for (int j = 0; j < 4; ++j) { const f32x4 w = wr4[64 * j];
        o8[64 * j] = (unsigned long long)pk2(v[j].x * rstd * w.x, v[j].y * rstd * w.y) | ((unsigned long long)pk2(v[j].z * rstd * w.z, v[j].w * rstd * w.w) << 32); }
}
__device__ __forceinline__ void rms_row_f32(const float* xrow, const float* nw, float* orow, int lane) {
    const GAS f32x4* xr = (const GAS f32x4*)xrow + lane; const GAS f32x4* wr4 = (const GAS f32x4*)nw + lane;
    f32x4 v[4]; float s = 0.f;
#pragma unroll
    for (int j = 0; j < 4; ++j) { v[j] = xr[64 * j]; s += (v[j].x * v[j].x + v[j].y * v[j].y) + (v[j].z * v[j].z + v[j].w * v[j].w); }
    const float rstd = 1.f / sqrtf(wave_sum(s) * (1.f / D) + RMS_EPS);
    GAS f32x4* o4 = (GAS f32x4*)orow + lane;
#pragma unroll
    for (int j = 0; j < 4; ++j) { const f32x4 w = wr4[64 * j]; o4[64 * j] = v[j] * rstd * w; }
}
__device__ __forceinline__ int t5_bucket(int rel) {
    const int ret = rel > 0 ? 16 : 0; const int n = rel < 0 ? -rel : rel;
    int b;
    if (n < 8) b = n; else if (n < 12) b = 8; else if (n < 16) b = 9; else if (n < 23) b = 10; else if (n < 32) b = 11; else if (n < 46) b = 12; else if (n < 64) b = 13; else if (n < 91) b = 14; else b = 15;
    return ret + b;
}

struct Args { const float* in[16]; float* out; unsigned char* ws; int ph_lo, ph_hi, li, pad; };

template <int MODE>
__device__ __forceinline__ void skinny_item(int item, const bf16* A, const bf16* Bt, int K, const float* xs, float* Y1S, bf16* A2s, const float* nw, float* rowsq_s, float* outs,
                                            LAS unsigned char* lds, int wave, int lane) {
    const int rg = item >> 2, cb = item & 3; const int fr = lane & 15, fq = lane >> 4;
    const bf16* ap = A + (size_t)(rg * 16 + fr) * K + fq * 8;
    const bf16* bp0 = Bt + (size_t)(cb * 256 + wave * 32 + fr) * K + fq * 8;
    const bf16* bp1 = bp0 + (size_t)16 * K;
    f32x4 acc0 = {0.f, 0.f, 0.f, 0.f}, acc1 = {0.f, 0.f, 0.f, 0.f};
#pragma unroll 4
    for (int k = 0; k < K; k += 32) {
        const bf16x8 a = *(const bf16x8*)(ap + k), b0 = *(const bf16x8*)(bp0 + k), b1 = *(const bf16x8*)(bp1 + k);
        acc0 = __builtin_amdgcn_mfma_f32_16x16x32_bf16(a, b0, acc0, 0, 0, 0);
        acc1 = __builtin_amdgcn_mfma_f32_16x16x32_bf16(a, b1, acc1, 0, 0, 0);
    }
    LAS float* P = (LAS float*)lds;
    float ssq[4];
#pragma unroll
    for (int r = 0; r < 4; ++r) {
        const int row = rg * 16 + fq * 4 + r; const int c0 = cb * 256 + wave * 32 + fr, c1 = c0 + 16;
        if (MODE == 0) {
            const float y0 = xs[(size_t)row * 1024 + c0] + acc0[r], y1 = xs[(size_t)row * 1024 + c1] + acc1[r];
            Y1S[(size_t)row * 1024 + c0] = y0; Y1S[(size_t)row * 1024 + c1] = y1;
            A2s[(size_t)row * 1024 + c0] = (bf16)f2bf(y0 * nw[c0]); A2s[(size_t)row * 1024 + c1] = (bf16)f2bf(y1 * nw[c1]);
            ssq[r] = y0 * y0 + y1 * y1;
        } else {
            outs[(size_t)row * 1024 + c0] = Y1S[(size_t)row * 1024 + c0] + acc0[r];
            outs[(size_t)row * 1024 + c1] = Y1S[(size_t)row * 1024 + c1] + acc1[r];
            ssq[r] = 0.f;
        }
    }
    if (MODE == 0) {
#pragma unroll
        for (int r = 0; r < 4; ++r) { float s = ssq[r]; s += __shfl_xor(s, 1); s += __shfl_xor(s, 2); s += __shfl_xor(s, 4); s += __shfl_xor(s, 8); if (fr == 0) P[(fq * 4 + r) * 8 + wave] = s; }
        LDS_WAIT(); __syncthreads();
        if (wave == 0 && lane < 16) { float t = 0.f;
#pragma unroll
            for (int w = 0; w < 8; ++w) t += P[lane * 8 + w];
            rowsq_s[(size_t)(rg * 16 + lane) * 4 + cb] = t; }
        LDS_WAIT(); __syncthreads();
    }
}

typedef short v4i16_t __attribute__((ext_vector_type(4)));
typedef unsigned v2u __attribute__((ext_vector_type(2)));
__device__ __forceinline__ unsigned offb(unsigned row, unsigned ch) { return 256u * row + 16u * (ch ^ (((row & 3u) << 2) | ((row >> 2) & 3u))); }
__device__ __forceinline__ unsigned cvtpk(float lo, float hi) { unsigned r; asm volatile("v_cvt_pk_bf16_f32 %0, %1, %2" : "=v"(r) : "v"(lo), "v"(hi)); return r; }
struct HgrnItem { int row0, klrow0, nch, nvalid, ebl0; const bf16* KL; const float* S0; float* Sout; };
constexpr int HG_BUF = 65536, HG_A = 131072, HG_RED = 131072 + 8192, HG_END = HG_RED + 2048;
static_assert(HG_END <= LDSCTL_OFF, "HGRN LDS map");
__device__ __forceinline__ void hgrn_stage_load(v4u (&st)[8], const HgrnItem& it, int c, int h, const bf16* QE, const bf16* QE2, const bf16* HI, int tid) {
#pragma unroll
    for (int k = 0; k < 8; ++k) {
        const int within = tid + 512 * (k & 1), row = within >> 4, ch = within & 15;
        const bf16* src;
        if ((k >> 1) == 0) src = QE + (size_t)(it.row0 + 64 * c + row) * 1024;
        else if ((k >> 1) == 1) src = QE2 + (size_t)(it.row0 + 64 * c + row) * 1024;
        else if ((k >> 1) == 2) src = it.KL + (size_t)(it.klrow0 + 64 * c + row) * 1024;
        else src = HI + (size_t)(it.row0 + 64 * c + row) * 1024;
        if (row < it.nvalid) st[k] = *(const v4u*)(src + h * 128 + ch * 8); else st[k] = (v4u){0u, 0u, 0u, 0u};
    }
}
__device__ __forceinline__ void hgrn_stage_write(const v4u (&st)[8], LAS unsigned char* buf, int tid) {
#pragma unroll
    for (int k = 0; k < 8; ++k) { const int within = tid + 512 * (k & 1), row = within >> 4, ch = within & 15; *(LAS v4u*)(buf + (k >> 1) * 16384 + offb(row, ch)) = st[k]; }
}
__device__ __forceinline__ void hgrn_item(LAS unsigned char* L, const HgrnItem it, int h, const bf16* QE, const bf16* QE2, const bf16* HI, const bf16* HOG, const bf16* GH, bf16* MERGED,
                                          const float* EBL, const float* gnorm, int tid, int wave, int lane) {
    const int r16 = lane & 15, q4 = lane >> 4, w = wave, tq = r16 >> 2, tp = r16 & 3;
    f32x4 S[8];
#pragma unroll
    for (int i = 0; i < 8; ++i)
#pragma unroll
        for (int r = 0; r < 4; ++r) S[i][r] = it.S0 ? it.S0[(size_t)(16 * i + 4 * q4 + r) * 128 + 16 * w + r16] : 0.f;
    const float gn = gnorm[16 * w + r16];
    v4u st[8];
    hgrn_stage_load(st, it, 0, h, QE, QE2, HI, tid);
    hgrn_stage_write(st, L, tid);
    LDS_WAIT(); __syncthreads();
    for (int c = 0; c < it.nch; ++c) {
        LAS unsigned char* B = L + (c & 1) * HG_BUF;
        LAS unsigned char* QEt = B; LAS unsigned char* Q2t = B + 16384; LAS unsigned char* KLt = B + 32768; LAS unsigned char* Vt = B + 49152;
        if (c + 1 < it.nch) hgrn_stage_load(st, it, c + 1, h, QE, QE2, HI, tid);
        f32x4 o[4];
#pragma unroll
        for (int tt = 0; tt < 4; ++tt) o[tt] = (f32x4){0.f, 0.f, 0.f, 0.f};
        {
            bf16x8 Sb[4];
#pragma unroll
            for (int s4 = 0; s4 < 4; ++s4) { v4u wv; wv.x = cvtpk(S[2 * s4][0], S[2 * s4][1]); wv.y = cvtpk(S[2 * s4][2], S[2 * s4][3]); wv.z = cvtpk(S[2 * s4 + 1][0], S[2 * s4 + 1][1]); wv.w = cvtpk(S[2 * s4 + 1][2], S[2 * s4 + 1][3]);
                Sb[s4] = __builtin_bit_cast(bf16x8, wv); }
#pragma unroll
            for (int tt = 0; tt < 4; ++tt) { const unsigned t = 16 * tt + r16;
#pragma unroll
                for (int s4 = 0; s4 < 4; ++s4) {
                    const v2u lo = *(const LAS v2u*)(QEt + offb(t, 4 * s4 + (q4 >> 1)) + 8 * (q4 & 1));
                    const v2u hi = *(const LAS v2u*)(QEt + offb(t, 4 * s4 + 2 + (q4 >> 1)) + 8 * (q4 & 1));
                    const v4u av = {lo.x, lo.y, hi.x, hi.y};
                    o[tt] = __builtin_amdgcn_mfma_f32_16x16x32_bf16(__builtin_bit_cast(bf16x8, av), Sb[s4], o[tt], 0, 0, 0);
                } }
        }
#pragma unroll
        for (int k2 = 0; k2 < 2; ++k2) {
            const int idx = 2 * w + k2, sb = idx >> 2, tb = idx & 3;
            f32x4 cacc = {0.f, 0.f, 0.f, 0.f};
            if (tb >= sb) {
#pragma unroll
                for (int ks = 0; ks < 4; ++ks) {
                    const bf16x8 a = *(const LAS bf16x8*)(KLt + offb(16 * sb + r16, 4 * ks + q4));
                    const bf16x8 bq = *(const LAS bf16x8*)(Q2t + offb(16 * tb + r16, 4 * ks + q4));
                    cacc = __builtin_amdgcn_mfma_f32_16x16x32_bf16(a, bq, cacc, 0, 0, 0);
                }
            }
            const int tval = 16 * tb + r16, s0 = 16 * sb + 4 * q4;
            float v[4];
#pragma unroll
            for (int r = 0; r < 4; ++r) v[r] = (tval >= s0 + r) ? cacc[r] : 0.f;
            v2u wv; wv.x = cvtpk(v[0], v[1]); wv.y = cvtpk(v[2], v[3]);
            *(LAS v2u*)(L + HG_A + tval * 128 + (((s0 >> 3) ^ ((tval >> 1) & 7)) << 4) + (s0 & 7) * 2) = wv;
        }
        LDS_WAIT(); __syncthreads();
        bf16x8 Vf[2];
#pragma unroll
        for (int s2 = 0; s2 < 2; ++s2) {
            const v4i16_t lo = __builtin_amdgcn_ds_read_tr16_b64_v4i16((LAS v4i16_t*)(Vt + offb(32 * s2 + 8 * q4 + tq, 2 * w + (tp >> 1)) + 8 * (tp & 1)));
            const v4i16_t hi = __builtin_amdgcn_ds_read_tr16_b64_v4i16((LAS v4i16_t*)(Vt + offb(32 * s2 + 8 * q4 + 4 + tq, 2 * w + (tp >> 1)) + 8 * (tp & 1)));
            Vf[s2] = (bf16x8){lo[0], lo[1], lo[2], lo[3], hi[0], hi[1], hi[2], hi[3]};
        }
#pragma unroll
        for (int tt = 0; tt < 4; ++tt) { const unsigned t = 16 * tt + r16;
#pragma unroll
            for (int s2 = 0; s2 < 2; ++s2) if (s2 == 0 || tt >= 2) {
                const bf16x8 a = *(const LAS bf16x8*)(L + HG_A + t * 128 + (((4 * s2 + q4) ^ ((t >> 1) & 7)) << 4));
                o[tt] = __builtin_amdgcn_mfma_f32_16x16x32_bf16(a, Vf[s2], o[tt], 0, 0, 0);
            } }
        {
            const float* eb = EBL + (size_t)(it.ebl0 + c) * 1024 + h * 128 + 4 * q4;
#pragma unroll
            for (int i = 0; i < 8; ++i) {
                const f32x4 e = *(const f32x4*)(eb + 16 * i);
                S[i] = S[i] * e;
#pragma unroll
                for (int s2 = 0; s2 < 2; ++s2) {
                    const v4i16_t lo = __builtin_amdgcn_ds_read_tr16_b64_v4i16((LAS v4i16_t*)(KLt + offb(32 * s2 + 8 * q4 + tq, 2 * i + (tp >> 1)) + 8 * (tp & 1)));
                    const v4i16_t hi = __builtin_amdgcn_ds_read_tr16_b64_v4i16((LAS v4i16_t*)(KLt + offb(32 * s2 + 8 * q4 + 4 + tq, 2 * i + (tp >> 1)) + 8 * (tp & 1)));
                    const bf16x8 a = (bf16x8){lo[0], lo[1], lo[2], lo[3], hi[0], hi[1], hi[2], hi[3]};
                    S[i] = __builtin_amdgcn_mfma_f32_16x16x32_bf16(a, Vf[s2], S[i], 0, 0, 0);
                }
            }
        }
        LAS float* RED = (LAS float*)(L + HG_RED);
#pragma unroll
        for (int tt = 0; tt < 4; ++tt)
#pragma unroll
            for (int r = 0; r < 4; ++r) { float ss = o[tt][r] * o[tt][r]; ss += __shfl_xor(ss, 1); ss += __shfl_xor(ss, 2); ss += __shfl_xor(ss, 4); ss += __shfl_xor(ss, 8);
                if (r16 == 0) RED[(16 * tt + 4 * q4 + r) * 8 + w] = ss; }
        LDS_WAIT(); __syncthreads();
#pragma unroll
        for (int tt = 0; tt < 4; ++tt)
#pragma unroll
            for (int r = 0; r < 4; ++r) { const int t = 16 * tt + 4 * q4 + r;
                if (t < it.nvalid) {
                    const f32x4 r0 = *(const LAS f32x4*)(RED + t * 8), r1 = *(const LAS f32x4*)(RED + t * 8 + 4);
                    const float tot = ((r0[0] + r0[1]) + (r0[2] + r0[3])) + ((r1[0] + r1[1]) + (r1[2] + r1[3]));
                    const float rstd = 1.0f / sqrtf(tot * (1.0f / 128.0f) + RMS_EPS);
                    const size_t gi = (size_t)(it.row0 + 64 * c + t) * 1024 + h * 128 + 16 * w + r16;
                    const float og = bf2f(HOG[gi]), gh = bf2f(GH[gi]), ag = bf2f(MERGED[gi]);
                    const float val = o[tt][r] * rstd * gn * (og * sigmoidf_(og));
                    MERGED[gi] = (bf16)f2bf(ag + sigmoidf_(gh) * val);
                } }
        if (c + 1 < it.nch) hgrn_stage_write(st, L + ((c + 1) & 1) * HG_BUF, tid);
        LDS_WAIT(); __syncthreads();
    }
#pragma unroll
    for (int i = 0; i < 8; ++i)
#pragma unroll
        for (int r = 0; r < 4; ++r) it.Sout[(size_t)(16 * i + 4 * q4 + r) * 128 + 16 * w + r16] = S[i][r];
}

__global__ void __launch_bounds__(NWAVES * 64, 2) mk_fwd(Args args) {
    extern __shared__ __attribute__((aligned(16))) unsigned char lds[];
    LAS unsigned char* L = (LAS unsigned char*)lds;
    volatile LAS unsigned* MISC = (volatile LAS unsigned*)(L + MISC_OFF);
    const int tid = threadIdx.x, lane = tid & 63, wave = __builtin_amdgcn_readfirstlane(tid >> 6);
    const int G = gridDim.x; const int bx = blockIdx.x;
    const int vcu = (G % 8 == 0) ? (bx % 8) * (G / 8) + bx / 8 : bx;
    unsigned char* ws = args.ws;
    gu32* ctl = (gu32*)(ws + WS_CTL);
    const float* x_prompt = args.in[0]; const float* x_sample = args.in[1]; const float* cache_k = args.in[2]; const float* cache_v = args.in[3];
    const float* state_in = args.in[4]; const float* norm_mix = args.in[5]; const float* w_in = args.in[6]; const float* w_out = args.in[7];
    const float* sinks = args.in[8]; const float* rel_tab = args.in[9]; const float* hgrn_lb = args.in[10]; const float* hgrn_norm = args.in[11];
    const float* norm_ffn = args.in[12]; const float* w_gu = args.in[13]; const float* w_dn = args.in[14]; const float* norm_final = args.in[15];
    float* out = args.out;
    bf16* WinT = (bf16*)(ws + WS_WIN); bf16* WoutT = (bf16*)(ws + WS_WOUT); bf16* WguT = (bf16*)(ws + WS_WGU); bf16* WdnT = (bf16*)(ws + WS_WDN);
    bf16* QB = (bf16*)(ws + WS_Q); bf16* KVB = (bf16*)(ws + WS_KV); bf16* HQB = (bf16*)(ws + WS_HQ); bf16* HFB = (bf16*)(ws + WS_HF); bf16* HIB = (bf16*)(ws + WS_HI);
    bf16* HOGB = (bf16*)(ws + WS_HOG); bf16* GAB = (bf16*)(ws + WS_GA); bf16* GHB = (bf16*)(ws + WS_GH);
    bf16* A2B = (bf16*)(ws + WS_A2); bf16* ACTB_ = (bf16*)(ws + WS_ACT);
    bf16* XN = (bf16*)out;
    float* BIAS2 = (float*)(ws + WS_BIAS); float* SINK2 = (float*)(ws + WS_SINK); float* LBV = (float*)(ws + WS_LB);
    float* ROWSQ = (float*)(ws + WS_ROWSQ); float* Y1S = (float*)(ws + WS_Y1S);
    bf16* KLP = (bf16*)((unsigned char*)out + ACTB); bf16* KLS = (bf16*)(ws + WS_KLS); float* EBL = (float*)(ws + WS_EBL);

    for (int u = tid; u < (LDS_BYTES - LDSCTL_OFF) / 4; u += NWAVES * 64) ((LAS unsigned*)(L + LDSCTL_OFF))[u] = 0u;
    __syncthreads();
    XcdBarrier bar; bar.bar = (unsigned*)(ctl + CW_BAR); bar.x = 0; bar.st = nullptr;
    if (N_LAUNCHES != PER_PHASE) bar = xcd_barrier_post((unsigned*)(ctl + CW_BAR), MISC + 8);
#define GRID_BAR() do { if (N_LAUNCHES != PER_PHASE) { xcd_barrier(bar); } } while (0)
    const int lo = args.ph_lo, hi = args.ph_hi;
#define IN(k) (lo <= (k) && (k) < hi)
#define BOTH(k) (IN(k) && IN((k) + 1))
    const int gw = vcu * NWAVES + wave, NGW = G * NWAVES;

    if (IN(0)) {
        LAS float* scr = (LAS float*)(L + wave * 16384);
        constexpr int I_IN = (D / 64) * (NIN / 32);
        for (int it = gw; it < I_IN; it += NGW) { const int nblk = NIN / 32, kb = it / nblk, nb = it % nblk; const int n0 = 32 * nb;
            int src = n0;
            if (n0 >= 1280 && n0 < 3328) { const int r = n0 - 1280; src = (((r >> 7) & 1) ? 2304 : 1280) + (r >> 8) * 128 + (r & 127); }
            transpose_item(w_in, D, NIN, WinT, 64 * kb, src, n0, scr, lane); }
        for (int m = gw; m < MROWS; m += NGW) {
            if (m < MP) rms_row_to_bf16(x_prompt + (size_t)m * D, norm_mix, XN + (size_t)m * D, lane);
            else if (m < MP + MS) rms_row_to_bf16(x_sample + (size_t)(m - MP) * D, norm_mix, XN + (size_t)m * D, lane);
            else { GAS unsigned long long* o8 = (GAS unsigned long long*)(XN + (size_t)m * D) + lane;
#pragma unroll
                for (int j = 0; j < 4; ++j) o8[64 * j] = 0ull; }
        }
        const int gt = vcu * (NWAVES * 64) + tid, NGT = G * NWAVES * 64;
        for (int i = gt; i < 16 * 256; i += NGT) { const int h = i >> 8, idx = i & 255; const int rel = idx - 191; BIAS2[i] = (idx < 255) ? rel_tab[t5_bucket(rel) * 16 + h] * LOG2E : 0.f; }
        for (int i = gt; i < 16; i += NGT) SINK2[i] = sinks[i] * LOG2E;
        for (int i = gt; i < 1024; i += NGT) LBV[i] = 1.0f / (1.0f + __expf(hgrn_lb[1024 + i] - hgrn_lb[i]));
        for (int i = gt; i < 8 * 112 * 32; i += NGT) {
            const int b = i / (112 * 32), r = i % (112 * 32), j = r >> 5, c4 = r & 31;
            const f32x4 kv = *(const f32x4*)(cache_k + ((size_t)(b * 128 + 16 + j) * 128 + c4 * 4));
            const f32x4 vv = *(const f32x4*)(cache_v + ((size_t)(b * 128 + 16 + j) * 128 + c4 * 4));
            *(f32x4*)(out + O_KS + ((size_t)(b * 128 + j) * 128 + c4 * 4)) = kv;
            *(f32x4*)(out + O_VS + ((size_t)(b * 128 + j) * 128 + c4 * 4)) = vv;
        }
        for (int i = gt; i < MROWS * 4; i += NGT) ROWSQ[i] = 0.f;
        if (BOTH(0)) GRID_BAR();
    }

    if (IN(1)) {
        pg8::Gemm g{XN, WinT, MROWS, NIN, D}; pg8::StaticOrder S; S.init(MROWS, NIN, G, bx);
        pg8::EpiProj E{QB, KVB, HQB, ACTB / 2, out, C2, HQB, HFB, KLP, KLS, EBL, LBV};
        pg8::gemm_phase<pg8::EpiProj, pg8::StaticOrder, true, true>(L, g, S, E);
        if (BOTH(1)) GRID_BAR();
    }

    if (IN(2)) {
        LAS float* Ks = (LAS float*)L;
        LAS float* Vs = Ks + 192 * 64;
        LAS float* Bs = Vs + 192 * 64;
        for (int unit = vcu; unit < 512 + 16; unit += G) {
            int qrow0, nq, nk, jstart, kvh, b; bool samp = unit >= 512;
            if (!samp) { b = unit >> 6; const int c = (unit >> 1) & 31; kvh = unit & 1; qrow0 = b * SEQ + c * 64; nq = 64; nk = 192; jstart = c >= 2 ? 0 : (2 - c) * 64; }
            else { const int us = unit - 512; b = us >> 1; kvh = us & 1; qrow0 = MP + b * 16; nq = 16; nk = 144; jstart = 0; }
            __syncthreads();
            for (int i = tid; i < nk * 16; i += 512) {
                const int j = i >> 4, c4 = (i & 15) * 4;
                f32x4 kf, vf;
                if (samp && j < 128) {
                    kf = *(const f32x4*)(cache_k + ((size_t)(b * 128 + j) * 128 + kvh * 64 + c4));
                    vf = *(const f32x4*)(cache_v + ((size_t)(b * 128 + j) * 128 + kvh * 64 + c4));
                } else if (j >= jstart) {
                    const size_t row = samp ? (size_t)(MP + b * 16 + (j - 128)) : (size_t)(qrow0 - 128 + j);
                    const uint2 kw = *(const uint2*)(KVB + row * 256 + kvh * 64 + c4); const uint2 vw = *(const uint2*)(KVB + row * 256 + 128 + kvh * 64 + c4);
                    kf = (f32x4){bflo(kw.x), bfhi(kw.x), bflo(kw.y), bfhi(kw.y)}; vf = (f32x4){bflo(vw.x), bfhi(vw.x), bflo(vw.y), bfhi(vw.y)};
                } else { kf = (f32x4){0.f, 0.f, 0.f, 0.f}; vf = kf; }
                *(LAS f32x4*)(Ks + j * 64 + c4) = kf; *(LAS f32x4*)(Vs + j * 64 + c4) = vf;
            }
            for (int i = tid; i < 8 * 256; i += 512) Bs[i] = BIAS2[(kvh * 8 + (i >> 8)) * 256 + (i & 255)];
            __syncthreads();
            const int g8 = wave, qi = lane; const int h16 = kvh * 8 + g8;
            if (qi < nq) {
                const size_t row = (size_t)(qrow0 + qi);
                float q[64];
#pragma unroll
                for (int c = 0; c < 8; ++c) { const v4u w = *(const v4u*)(QB + row * 1024 + h16 * 64 + c * 8);
                    q[c * 8 + 0] = bflo(w.x); q[c * 8 + 1] = bfhi(w.x); q[c * 8 + 2] = bflo(w.y); q[c * 8 + 3] = bfhi(w.y); q[c * 8 + 4] = bflo(w.z); q[c * 8 + 5] = bfhi(w.z); q[c * 8 + 6] = bflo(w.w); q[c * 8 + 7] = bfhi(w.w); }
                const float sk = SINK2[h16];
                float mx = sk;
                const LAS float* brow = Bs + g8 * 256 + 63 - qi;
                for (int j = jstart; j < nk; ++j) {
                    float s = 0.f; const LAS f32x4* kr = (const LAS f32x4*)(Ks + j * 64);
#pragma unroll
                    for (int c = 0; c < 16; ++c) { const f32x4 kk = kr[c]; s += q[c * 4] * kk.x + q[c * 4 + 1] * kk.y + q[c * 4 + 2] * kk.z + q[c * 4 + 3] * kk.w; }
                    s += brow[j];
                    mx = fmaxf(mx, s);
                }
                float l = __builtin_amdgcn_exp2f(sk - mx);
                float o[64];
#pragma unroll
                for (int c = 0; c < 64; ++c) o[c] = 0.f;
                for (int j = jstart; j < nk; ++j) {
                    float s = 0.f; const LAS f32x4* kr = (const LAS f32x4*)(Ks + j * 64);
#pragma unroll
                    for (int c = 0; c < 16; ++c) { const f32x4 kk = kr[c]; s += q[c * 4] * kk.x + q[c * 4 + 1] * kk.y + q[c * 4 + 2] * kk.z + q[c * 4 + 3] * kk.w; }
                    s += brow[j];
                    const float p = __builtin_amdgcn_exp2f(s - mx);
                    l += p;
                    const LAS f32x4* vr = (const LAS f32x4*)(Vs + j * 64);
#pragma unroll
                    for (int c = 0; c < 16; ++c) { const f32x4 vv = vr[c]; o[c * 4] += p * vv.x; o[c * 4 + 1] += p * vv.y; o[c * 4 + 2] += p * vv.z; o[c * 4 + 3] += p * vv.w; }
                }
                const float rl = 1.0f / l;
#pragma unroll
                for (int c = 0; c < 8; ++c) {
                    const v4u gw4 = *(const v4u*)(GAB + row * 1024 + h16 * 64 + c * 8);
                    float r[8]; const unsigned gws[4] = {gw4.x, gw4.y, gw4.z, gw4.w};
#pragma unroll
                    for (int e = 0; e < 4; ++e) { r[2 * e] = o[c * 8 + 2 * e] * rl * sigmoidf_(bflo(gws[e])); r[2 * e + 1] = o[c * 8 + 2 * e + 1] * rl * sigmoidf_(bfhi(gws[e])); }
                    v4u w; w.x = pk2(r[0], r[1]); w.y = pk2(r[2], r[3]); w.z = pk2(r[4], r[5]); w.w = pk2(r[6], r[7]);
                    *(v4u*)(QB + row * 1024 + h16 * 64 + c * 8) = w;
                }
            }
        }
        if (BOTH(2)) GRID_BAR();
    }

    if (IN(3)) {
        {
            LAS float* scr = (LAS float*)(L + wave * 16384);
            constexpr int I_O = (D / 64) * (D / 32), I_GU = (D / 64) * (NGU / 32), I_DN = (DFF / 64) * (D / 32);
            const int cw = ((vcu & 3) == 0) ? -1 : ((vcu >> 2) * 3 + (vcu & 3) - 1) * NWAVES + wave, NCW = (G / 4) * 3 * NWAVES;
            for (int it = cw; it >= 0 && it < I_O + I_GU + I_DN; it += NCW) {
                int r = it;
                if (r < I_O) { const int nblk = D / 32, kb = r / nblk, nb = r % nblk; transpose_item(w_out, D, D, WoutT, 64 * kb, 32 * nb, 32 * nb, scr, lane); continue; } r -= I_O;
                if (r < I_GU) { const int nblk = NGU / 32, kb = r / nblk, nb = r % nblk; const int n0 = 32 * nb;
                    const int src = ((n0 >> 7) & 1) * DFF + (n0 >> 8) * 128 + (n0 & 127);
                    transpose_item(w_gu, D, NGU, WguT, 64 * kb, src, n0, scr, lane); continue; } r -= I_GU;
                { const int nblk = D / 32, kb = r / nblk, nb = r % nblk; transpose_item(w_dn, DFF, D, WdnT, 64 * kb, 32 * nb, 32 * nb, scr, lane); }
            }
            __syncthreads();
        }
        if ((vcu & 3) == 0) {
            const int item = vcu >> 2, sb = item >> 3, h = item & 7;
            HgrnItem ip{sb * SEQ, sb * SEQ, SEQ / 64, 64, sb * 32, KLP, nullptr, out + O_SP + (size_t)(sb * 8 + h) * 128 * 128};
            hgrn_item(L, ip, h, HQB, HFB, HIB, HOGB, GHB, QB, EBL, hgrn_norm, tid, wave, lane);
            HgrnItem is{MP + sb * 16, sb * 16, 1, 16, 256 + sb, KLS, state_in + (size_t)(sb * 8 + h) * 128 * 128, out + O_SS + (size_t)(sb * 8 + h) * 128 * 128};
            hgrn_item(L, is, h, HQB, HFB, HIB, HOGB, GHB, QB, EBL, hgrn_norm, tid, wave, lane);
        }
        if (BOTH(3)) GRID_BAR();
    }

    if (IN(4)) {
        if (vcu < 32) skinny_item<0>(vcu, QB + (size_t)MP * 1024, WoutT, D, x_sample, Y1S, A2B + (size_t)MP * 1024, norm_ffn, ROWSQ + (size_t)MP * 4, nullptr, L, wave, lane);
        __syncthreads();
        pg8::Gemm g{QB, WoutT, MP, D, D}; pg8::StaticOrder S; S.init(MP, D, G, bx);
        pg8::EpiOut E{x_prompt, out, A2B, norm_ffn, ROWSQ};
        pg8::gemm_phase<pg8::EpiOut, pg8::StaticOrder, false, true>(L, g, S, E);
        if (BOTH(4)) GRID_BAR();
    }

    if (IN(5)) {
        pg8::Gemm g{A2B, WguT, MROWS, NGU, D}; pg8::StaticOrder S; S.init(MROWS, NGU, G, bx);
        pg8::EpiGU E{ACTB_, ROWSQ};
        pg8::gemm_phase<pg8::EpiGU, pg8::StaticOrder, true, true>(L, g, S, E);
        if (BOTH(5)) GRID_BAR();
    }

    if (IN(6)) {
        if (vcu < 32) skinny_item<1>(vcu, ACTB_ + (size_t)MP * DFF, WdnT, DFF, nullptr, Y1S, nullptr, nullptr, nullptr, out + O_YS, L, wave, lane);
        __syncthreads();
        pg8::Gemm g{ACTB_, WdnT, MP, D, DFF}; pg8::StaticOrder S; S.init(MP, D, G, bx);
        pg8::EpiDown E{out};
        pg8::gemm_phase<pg8::EpiDown, pg8::StaticOrder, false, true>(L, g, S, E);
        if (BOTH(6)) GRID_BAR();
    }

    if (IN(7)) {
        for (int m = gw; m < MP + MS; m += NGW) { float* r = (m < MP) ? out + (size_t)m * D : out + O_YS + (size_t)(m - MP) * D; rms_row_f32(r, norm_final, r, lane); }
    }
#undef IN
#undef BOTH
}

extern "C" void kernel_launch(void* const* d_in, const int* in_sizes, int n_in, void* d_out, int out_size, void* d_ws, size_t ws_size, hipStream_t stream) {
    if (n_in != 16 || ws_size < WS_END) { fprintf(stderr, "kernel_launch: unexpected n_in %d / ws_size %zu\n", n_in, ws_size); return; }
    (void)hipFuncSetAttribute((const void*)mk_fwd, hipFuncAttributeMaxDynamicSharedMemorySize, LDS_BYTES);
    const int grid = 256;
    (void)hipMemsetAsync((char*)d_ws + WS_CTL, 0, CTL_ZERO_BYTES, stream);
    Args a{};
    for (int i = 0; i < 16; ++i) a.in[i] = (const float*)d_in[i];
    a.out = (float*)d_out; a.ws = (unsigned char*)d_ws;
    if (N_LAUNCHES == 1) {
        a.ph_lo = 0; a.ph_hi = PER_PHASE; a.li = 0;
        hipLaunchKernelGGL(mk_fwd, dim3(grid), dim3(NWAVES * 64), LDS_BYTES, stream, a);
    } else {
        for (int li = 0; li < PER_PHASE; ++li) { a.ph_lo = li; a.ph_hi = li + 1; a.li = li;
            hipLaunchKernelGGL(mk_fwd, dim3(grid), dim3(NWAVES * 64), LDS_BYTES, stream, a); }
    }
}
```

```cpp
#include <hip/hip_runtime.h>
#include <cstdio>
#include <cstdint>

#ifndef PROBE_MASK
#define PROBE_MASK 0
#endif
#ifndef MK_N_LAUNCHES
#define MK_N_LAUNCHES 1
#endif

constexpr int O_YP = 0, O_YS = 16777216, O_KP = 16908288, O_VP = 17039360, O_SP = 17170432, O_KS = 18219008, O_VS = 18350080, O_SS = 18481152;
namespace pg8 {
#define PG8_LAS __attribute__((address_space(3)))
typedef unsigned short bf16_t;
typedef short bf16x8 __attribute__((ext_vector_type(8)));
typedef float f32x4 __attribute__((ext_vector_type(4)));
typedef unsigned u32x4 __attribute__((ext_vector_type(4)));
constexpr int BM = 256, BK = 64, HALF = 128, HTB = HALF * BK * 2, STAGE_BYTES = 8 * HTB, NXCD = 8, WGM = 8;

__host__ __device__ __forceinline__ int lds_byte(int r, int c) { const int st = (r >> 4) * 2 + (c >> 5), rr = r & 15, cc = c & 31, ob = rr * 64 + cc * 2; return st * 1024 + (ob ^ (((ob >> 9) & 1) << 5)); }
__host__ __device__ __forceinline__ void stage_rc(int b, int& R, int& C) { const int st = b / 1024, sb = b % 1024, swz = sb ^ (((sb >> 9) & 1) << 5); R = (st >> 1) * 16 + swz / 64; C = (st & 1) * 32 + (swz % 64) / 2; }
__host__ __device__ __forceinline__ int perm32(int rho) { const int n = rho >> 4, i = rho & 15; return 8 * (i >> 2) + 4 * n + (i & 3); }

struct Unit { int pm, pn; };
struct Gemm { const bf16_t* A; const bf16_t* Bt; int M, N, K; };

struct StaticOrder {
    int nM, nN, nwg, G, c;
    __host__ __device__ void init(int M, int N, int G_, int c_) { nM = M / BM; nN = N / BM; nwg = nM * nN; G = G_; c = c_; }
    __host__ __device__ bool next(int i, Unit& u) const {
        const long L = (long)i * G + c; if (L >= nwg) return false;
        int wgid = (int)L; { const int q = nwg / NXCD, r = nwg % NXCD, xcd = wgid % NXCD, off = wgid / NXCD; wgid = (xcd < r ? xcd * (q + 1) : r * (q + 1) + (xcd - r) * q) + off; }
        const int nig = WGM * nN, gid = wgid / nig, fm = gid * WGM, gsz = (nM - fm) < WGM ? (nM - fm) : WGM;
        u.pm = fm + ((wgid % nig) % gsz); u.pn = (wgid % nig) / gsz; return true;
    }
    __device__ __forceinline__ void a_ready(const Unit&) const {}
    __device__ __forceinline__ void done(const Unit&) const {}
};

__device__ __forceinline__ unsigned cvt_pk_bf16(float lo, float hi) { unsigned r; asm volatile("v_cvt_pk_bf16_f32 %0, %1, %2" : "=v"(r) : "v"(lo), "v"(hi)); return r; }


template <int CTRL> __device__ __forceinline__ float dpp0(float v) { return __builtin_bit_cast(float, __builtin_amdgcn_update_dpp(0, __builtin_bit_cast(int, v), CTRL, 0xf, 0xf, true)); }
__device__ __forceinline__ float row_scan16(float v) { v += dpp0<0x111>(v); v += dpp0<0x112>(v); v += dpp0<0x114>(v); v += dpp0<0x118>(v); return v; }
struct EpiProj {
    static constexpr bool PERM = true, AFTER_DRAIN = false;
    bf16_t* Q; bf16_t* KV; bf16_t* H0; size_t hstride; float* out; float qscale;
    bf16_t* QE; bf16_t* QE2; bf16_t* KLP; bf16_t* KLS; float* EBL; const float* lbv;
    __device__ __forceinline__ void gate_tile(const f32x4 (&acc)[2][2][4][2], const Unit& u, int wr, int wc, int fr, int fq) const {
        const int lane = fq * 16 + fr;
        const int colb = (u.pn - 5) * 128 + wc * 32 + 8 * fq;
        const bool samp = (u.pm == 64);
#pragma unroll
        for (int ai = 0; ai < 2; ++ai) {
#pragma unroll
            for (int n = 0; n < 2; ++n) {
                const f32x4 lb = *(const f32x4*)(lbv + colb + 4 * n);
                float gs[4][4], ff[4][4], tot[4][4];
#pragma unroll
                for (int m = 0; m < 4; ++m)
#pragma unroll
                    for (int i = 0; i < 4; ++i) {
                        const float hf = acc[ai][1][m][n][i];
                        const float sg = __builtin_amdgcn_rcpf(1.0f + __builtin_amdgcn_exp2f(-1.4426950408889634f * hf));
                        const float f = lb[i] + (1.0f - lb[i]) * sg;
                        ff[m][i] = f;
                        const float g = __builtin_amdgcn_logf(f) * 0.6931471805599453f;
                        const float sc = row_scan16(g);
                        gs[m][i] = sc;
                        tot[m][i] = __shfl(sc, lane | 15, 64);
                    }
                float bl[4][4];
#pragma unroll
                for (int i = 0; i < 4; ++i) {
                    if (!samp) {
                        float pre = 0.f;
#pragma unroll
                        for (int m = 0; m < 4; ++m) { gs[m][i] += pre; pre += tot[m][i]; }
#pragma unroll
                        for (int m = 0; m < 4; ++m) bl[m][i] = pre;
                    } else {
#pragma unroll
                        for (int m = 0; m < 4; ++m) bl[m][i] = tot[m][i];
                    }
                }
#pragma unroll
                for (int m = 0; m < 4; ++m) {
                    const int row = u.pm * BM + ai * HALF + wr * 64 + m * 16 + fr;
                    float qe[4], q2[4], kl[4];
#pragma unroll
                    for (int i = 0; i < 4; ++i) {
                        const float q = acc[ai][0][m][n][i], b = gs[m][i], d = bl[m][i] - b;
                        qe[i] = q * __builtin_amdgcn_exp2f(1.4426950408889634f * b);
                        q2[i] = q * __builtin_amdgcn_exp2f(-1.4426950408889634f * d);
                        kl[i] = (1.0f - ff[m][i]) * __builtin_amdgcn_exp2f(1.4426950408889634f * d);
                    }
                    const size_t o = (size_t)row * 1024 + colb + 4 * n;
                    uint2 w;
                    w.x = cvt_pk_bf16(qe[0], qe[1]); w.y = cvt_pk_bf16(qe[2], qe[3]); *(uint2*)(QE + o) = w;
                    w.x = cvt_pk_bf16(q2[0], q2[1]); w.y = cvt_pk_bf16(q2[2], q2[3]); *(uint2*)(QE2 + o) = w;
                    w.x = cvt_pk_bf16(kl[0], kl[1]); w.y = cvt_pk_bf16(kl[2], kl[3]);
                    if (row < 16384) *(uint2*)(KLP + o) = w; else *(uint2*)(KLS + (size_t)(row - 16384) * 1024 + colb + 4 * n) = w;
                }
                if (fr == 0) {
                    if (!samp) {
                        const int ci = u.pm * 4 + ai * 2 + wr;
                        f32x4 e;
#pragma unroll
                        for (int i = 0; i < 4; ++i) e[i] = __builtin_amdgcn_exp2f(1.4426950408889634f * bl[0][i]);
                        *(f32x4*)(EBL + (size_t)ci * 1024 + colb + 4 * n) = e;
                    } else if (ai == 0) {
#pragma unroll
                        for (int m = 0; m < 4; ++m) { f32x4 e;
#pragma unroll
                            for (int i = 0; i < 4; ++i) e[i] = __builtin_amdgcn_exp2f(1.4426950408889634f * bl[m][i]);
                            *(f32x4*)(EBL + (size_t)(256 + wr * 4 + m) * 1024 + colb + 4 * n) = e; }
                    }
                }
            }
        }
    }
    __device__ __forceinline__ void operator()(const f32x4 (&acc)[2][2][4][2], const Unit& u, int wr, int wc, int fr, int fq) const {
        if (u.pn >= 5 && u.pn <= 12) { gate_tile(acc, u, wr, wc, fr, fq); return; }
        const int row0 = u.pm * BM + wr * 64 + fr;
        bf16_t* base; int ldc, c0; float sc = 1.f;
        if (u.pn < 4) { base = Q; ldc = 1024; c0 = u.pn * 256; sc = qscale; }
        else if (u.pn == 4) { base = KV; ldc = 256; c0 = 0; }
        else { const int t = (u.pn - 5) >> 2; base = H0 + (size_t)t * hstride; ldc = 1024; c0 = ((u.pn - 5) & 3) * 256; }
        const int col0 = c0 + wc * 32 + 8 * fq;
#pragma unroll
        for (int ai = 0; ai < 2; ++ai)
#pragma unroll
            for (int m = 0; m < 4; ++m) {
                const int row = row0 + ai * HALF + m * 16;
                bf16_t* rowp = base + (size_t)row * ldc + col0;
#pragma unroll
                for (int bj = 0; bj < 2; ++bj) {
                    const f32x4 v0 = acc[ai][bj][m][0] * sc, v1 = acc[ai][bj][m][1] * sc;
                    u32x4 w; w.x = cvt_pk_bf16(v0[0], v0[1]); w.y = cvt_pk_bf16(v0[2], v0[3]); w.z = cvt_pk_bf16(v1[0], v1[1]); w.w = cvt_pk_bf16(v1[2], v1[3]);
                    *(u32x4*)(rowp + bj * HALF) = w;
                }
                if (u.pn == 4) {
                    int orow = -1; int okb = 0, ovb = 0;
                    if (row < 16384) { const int t = row & 2047; if (t >= 1920) { orow = (row >> 11) * 128 + (t - 1920); okb = O_KP; ovb = O_VP; } }
                    else if (row < 16512) { const int rs = row - 16384; orow = (rs >> 4) * 128 + 112 + (rs & 15); okb = O_KS; ovb = O_VS; }
                    if (orow >= 0) {
                        float* kd = out + okb + (size_t)orow * 128 + wc * 32 + 8 * fq;
                        float* vd = out + ovb + (size_t)orow * 128 + wc * 32 + 8 * fq;
                        *(f32x4*)(kd) = acc[ai][0][m][0]; *(f32x4*)(kd + 4) = acc[ai][0][m][1];
                        *(f32x4*)(vd) = acc[ai][1][m][0]; *(f32x4*)(vd + 4) = acc[ai][1][m][1];
                    }
                }
            }
    }
};

struct EpiOut {
    static constexpr bool PERM = true, AFTER_DRAIN = true;
    const float* x; float* Y1; bf16_t* A2; const float* nw; float* rowsq;
    __device__ __forceinline__ void fused(f32x4 (&acc)[2][2][4][2], const Unit& u, int wr, int wc, int fr, int fq, PG8_LAS unsigned char* lds, int wid, int lane) const {
        PG8_LAS float* P = (PG8_LAS float*)lds;
        const int col0 = u.pn * BM + wc * 32 + 8 * fq;
        f32x4 nwv[2][2];
#pragma unroll
        for (int bj = 0; bj < 2; ++bj)
#pragma unroll
            for (int n = 0; n < 2; ++n) nwv[bj][n] = *(const f32x4*)(nw + col0 + bj * HALF + 4 * n);
#pragma unroll
        for (int ai = 0; ai < 2; ++ai)
#pragma unroll
            for (int m = 0; m < 4; ++m) {
                const int rl = ai * HALF + wr * 64 + m * 16 + fr; const size_t off = (size_t)(u.pm * BM + rl) * 1024 + col0;
                float s = 0.f;
#pragma unroll
                for (int bj = 0; bj < 2; ++bj) {
                    const f32x4 xa = *(const f32x4*)(x + off + bj * HALF), xb = *(const f32x4*)(x + off + bj * HALF + 4);
                    const f32x4 y0 = acc[ai][bj][m][0] + xa, y1 = acc[ai][bj][m][1] + xb;
                    *(f32x4*)(Y1 + off + bj * HALF) = y0; *(f32x4*)(Y1 + off + bj * HALF + 4) = y1;
                    s += (y0[0] * y0[0] + y0[1] * y0[1]) + (y0[2] * y0[2] + y0[3] * y0[3]) + (y1[0] * y1[0] + y1[1] * y1[1]) + (y1[2] * y1[2] + y1[3] * y1[3]);
                    const f32x4 a0 = y0 * nwv[bj][0], a1 = y1 * nwv[bj][1];
                    u32x4 w; w.x = cvt_pk_bf16(a0[0], a0[1]); w.y = cvt_pk_bf16(a0[2], a0[3]); w.z = cvt_pk_bf16(a1[0], a1[1]); w.w = cvt_pk_bf16(a1[2], a1[3]);
                    *(u32x4*)(A2 + off + bj * HALF) = w;
                }
                s += __shfl_xor(s, 16); s += __shfl_xor(s, 32);
                if (fq == 0) P[rl * 4 + wc] = s;
                asm volatile("" ::: "memory");
            }
        asm volatile("s_waitcnt lgkmcnt(0)" ::: "memory"); __builtin_amdgcn_s_barrier(); asm volatile("" ::: "memory");
        const int tid = wid * 64 + lane;
        if (tid < 256) { const float t = (P[tid * 4 + 0] + P[tid * 4 + 1]) + (P[tid * 4 + 2] + P[tid * 4 + 3]); rowsq[(size_t)(u.pm * BM + tid) * 4 + u.pn] = t; }
        asm volatile("s_waitcnt lgkmcnt(0)" ::: "memory"); __builtin_amdgcn_s_barrier(); asm volatile("" ::: "memory");
    }
};

struct EpiGU {
    static constexpr bool PERM = true, AFTER_DRAIN = false;
    bf16_t* ACT; const float* rowsq;
    __device__ __forceinline__ void operator()(const f32x4 (&acc)[2][2][4][2], const Unit& u, int wr, int wc, int fr, int fq) const {
        const int row0 = u.pm * BM + wr * 64 + fr, col0 = u.pn * HALF + wc * 32 + 8 * fq;
#pragma unroll
        for (int ai = 0; ai < 2; ++ai)
#pragma unroll
            for (int m = 0; m < 4; ++m) {
                const int row = row0 + ai * HALF + m * 16;
                const f32x4 p = *(const f32x4*)(rowsq + (size_t)row * 4);
                const float rstd = 1.0f / sqrtf(((p[0] + p[1]) + (p[2] + p[3])) * (1.0f / 1024.0f) + 1e-6f);
                float r[8];
#pragma unroll
                for (int n = 0; n < 2; ++n)
#pragma unroll
                    for (int i = 0; i < 4; ++i) {
                        const float g = acc[ai][0][m][n][i] * rstd, uu = acc[ai][1][m][n][i] * rstd;
                        const float sg = __builtin_amdgcn_rcpf(1.0f + __builtin_amdgcn_exp2f(-1.4426950408889634f * g));
                        r[n * 4 + i] = g * sg * uu;
                    }
                u32x4 w; w.x = cvt_pk_bf16(r[0], r[1]); w.y = cvt_pk_bf16(r[2], r[3]); w.z = cvt_pk_bf16(r[4], r[5]); w.w = cvt_pk_bf16(r[6], r[7]);
                *(u32x4*)(ACT + (size_t)row * 2816 + col0) = w;
            }
    }
};

struct EpiDown {
    static constexpr bool PERM = false, AFTER_DRAIN = false;
    float* Y;
    __device__ __forceinline__ void operator()(const f32x4 (&acc)[2][2][4][2], const Unit& u, int wr, int wc, int fr, int fq) const {
        const int row0 = u.pm * BM + wr * 64 + fr, col0 = u.pn * BM + wc * 32 + 4 * fq;
#pragma unroll
        for (int ai = 0; ai < 2; ++ai)
#pragma unroll
            for (int m = 0; m < 4; ++m) { float* rowp = Y + (size_t)(row0 + ai * HALF + m * 16) * 1024 + col0;
#pragma unroll
                for (int bj = 0; bj < 2; ++bj)
#pragma unroll
                    for (int n = 0; n < 2; ++n) { const f32x4 b = *(const f32x4*)(rowp + bj * HALF + n * 16); *(f32x4*)(rowp + bj * HALF + n * 16) = acc[ai][bj][m][n] + b; }
                if (m & 1) asm volatile("" ::: "memory"); }
    }
};

template <class Epi, class Sched, bool ALIGN_EPI = false, bool SP2 = false>
__device__ __forceinline__ void gemm_phase(PG8_LAS unsigned char* lds, const Gemm g, const Sched& S, const Epi& E) {
    const int tid = threadIdx.x, wid = __builtin_amdgcn_readfirstlane(tid >> 6), lane = tid & 63, wr = wid >> 2, wc = wid & 3, fr = lane & 15, fq = lane >> 4;
    const int K = g.K, nt = K / BK;
    unsigned voffA[2], voffB[2];
#pragma unroll
    for (int i = 0; i < 2; ++i) { int R, C; stage_rc(tid * 16 + i * 8192, R, C); const int Rb = Epi::PERM ? ((R & ~31) + perm32(R & 31)) : R;
        voffA[i] = (unsigned)(R * K + C) * 2u; voffB[i] = (unsigned)(Rb * K + C) * 2u; }
    const size_t kstep = (size_t)(BK * 2);
    const size_t hstep = (size_t)HALF * K * 2;
    const size_t tstep = 2 * hstep;
    const unsigned ldsw = (unsigned)wid * 1024u;
    const int aoff = lds_byte(wr * 64 + fr, fq * 8), boff = lds_byte(wc * 32 + fr, fq * 8);
#define PG8_SA(b, h) (((b) * 2 + (h)) * HTB)
#define PG8_SB(b, h) ((4 + (b) * 2 + (h)) * HTB)
#define PG8_STAGE(bufoff, gbase, voff) do { _Pragma("unroll") for (int _i = 0; _i < 2; ++_i) \
        __builtin_amdgcn_global_load_lds((const unsigned*)((const char*)(gbase) + (voff)[_i]), (PG8_LAS unsigned*)(lds + (bufoff) + ldsw + _i * 8192), 16, 0, 0); } while (0)
#define PG8_LDA(dst, b, h) do { _Pragma("unroll") for (int m = 0; m < 4; ++m) _Pragma("unroll") for (int k = 0; k < 2; ++k) dst[m][k] = *(const PG8_LAS bf16x8*)(lds + PG8_SA(b, h) + aoff + m * 2048 + k * 1024); } while (0)
#define PG8_LDB(dst, b, h) do { _Pragma("unroll") for (int n = 0; n < 2; ++n) _Pragma("unroll") for (int k = 0; k < 2; ++k) dst[n][k] = *(const PG8_LAS bf16x8*)(lds + PG8_SB(b, h) + boff + n * 2048 + k * 1024); } while (0)
#define PG8_MMA(ai, bj, At, Bt) do { __builtin_amdgcn_s_setprio(1); _Pragma("unroll") for (int m = 0; m < 4; ++m) _Pragma("unroll") for (int n = 0; n < 2; ++n) _Pragma("unroll") for (int k = 0; k < 2; ++k) \
        acc[ai][bj][m][n] = __builtin_amdgcn_mfma_f32_16x16x32_bf16(Bt[n][k], At[m][k], acc[ai][bj][m][n], 0, 0, 0); __builtin_amdgcn_s_setprio(0); } while (0)
#define PG8_WAIT_V(n) asm volatile("s_waitcnt vmcnt(" #n ")" ::: "memory")
#define PG8_WAIT_L(n) asm volatile("s_waitcnt lgkmcnt(" #n ")" ::: "memory")
#define PG8_BAR __builtin_amdgcn_s_barrier()
#define PG8_SCHED __builtin_amdgcn_sched_barrier(0)
    Unit cur, nxt; int ui = 0;
    if (!S.next(0, cur)) return;
    f32x4 acc[2][2][4][2];
#pragma unroll
    for (int a = 0; a < 2; ++a)
#pragma unroll
        for (int b = 0; b < 2; ++b)
#pragma unroll
            for (int m = 0; m < 4; ++m)
#pragma unroll
                for (int n = 0; n < 2; ++n) acc[a][b][m][n] = (f32x4){0.f, 0.f, 0.f, 0.f};
    bf16x8 At[4][2], B0[2][2], B1[2][2];
    const char* cA = (const char*)g.A + (size_t)cur.pm * tstep; const char* cB = (const char*)g.Bt + (size_t)cur.pn * tstep;
    S.a_ready(cur);
    if constexpr (SP2) {
        PG8_STAGE(PG8_SB(0, 0), cB, voffB); PG8_STAGE(PG8_SB(0, 1), cB + hstep, voffB); PG8_STAGE(PG8_SA(0, 0), cA, voffA); PG8_STAGE(PG8_SA(0, 1), cA + hstep, voffA);
        if (wr == 1) PG8_BAR;
        PG8_WAIT_V(2); PG8_BAR;
        PG8_STAGE(PG8_SB(1, 0), cB + kstep, voffB); PG8_STAGE(PG8_SA(1, 0), cA + kstep, voffA); PG8_STAGE(PG8_SB(1, 1), cB + hstep + kstep, voffB);
        PG8_WAIT_V(6); PG8_BAR;
    } else {
        PG8_STAGE(PG8_SB(0, 0), cB, voffB); PG8_STAGE(PG8_SA(0, 0), cA, voffA); PG8_STAGE(PG8_SB(0, 1), cB + hstep, voffB); PG8_STAGE(PG8_SA(0, 1), cA + hstep, voffA);
        if (wr == 1) PG8_BAR;
        PG8_WAIT_V(4); PG8_BAR;
        PG8_STAGE(PG8_SB(1, 0), cB + kstep, voffB); PG8_STAGE(PG8_SA(1, 0), cA + kstep, voffA); PG8_STAGE(PG8_SB(1, 1), cB + hstep + kstep, voffB);
        PG8_WAIT_V(6); PG8_BAR;
    }
    for (;;) {
        const bool has_next = S.next(ui + 1, nxt);
        const char* nA = has_next ? (const char*)g.A + (size_t)nxt.pm * tstep : cA; const char* nB = has_next ? (const char*)g.Bt + (size_t)nxt.pn * tstep : cB;
        for (int t = 0; t < nt; t += 2) {
            const bool last = (t == nt - 2);
            const char* a1 = cA + (size_t)(t + 1) * kstep;
            const char* a2 = last ? nA : cA + (size_t)(t + 2) * kstep; const char* b2 = last ? nB : cB + (size_t)(t + 2) * kstep;
            const char* a3 = a2 + kstep; const char* b3 = b2 + kstep;
            if (last && has_next) S.a_ready(nxt);
            if constexpr (SP2) {
            PG8_LDB(B0, 0, 0); PG8_LDB(B1, 0, 1); PG8_SCHED; PG8_LDA(At, 0, 0); PG8_STAGE(PG8_SA(1, 1), a1 + hstep, voffA);
            PG8_WAIT_V(8); PG8_WAIT_L(0); PG8_BAR; PG8_MMA(0, 0, At, B0); PG8_MMA(0, 1, At, B1); PG8_BAR; PG8_SCHED;
            PG8_LDA(At, 0, 1); PG8_STAGE(PG8_SB(0, 0), b2, voffB); PG8_STAGE(PG8_SB(0, 1), b2 + hstep, voffB); PG8_STAGE(PG8_SA(0, 0), a2, voffA);
            PG8_WAIT_V(8); PG8_WAIT_L(0); PG8_BAR; PG8_MMA(1, 0, At, B0); PG8_MMA(1, 1, At, B1); PG8_BAR; PG8_SCHED;
            PG8_LDB(B0, 1, 0); PG8_LDB(B1, 1, 1); PG8_SCHED; PG8_LDA(At, 1, 0); PG8_STAGE(PG8_SA(0, 1), a2 + hstep, voffA);
            PG8_WAIT_V(8); PG8_WAIT_L(0); PG8_BAR; PG8_MMA(0, 0, At, B0); PG8_MMA(0, 1, At, B1); PG8_BAR; PG8_SCHED;
            PG8_LDA(At, 1, 1); PG8_STAGE(PG8_SB(1, 0), b3, voffB); PG8_STAGE(PG8_SB(1, 1), b3 + hstep, voffB); PG8_STAGE(PG8_SA(1, 0), a3, voffA);
            PG8_WAIT_V(8); PG8_WAIT_L(0); PG8_BAR; PG8_MMA(1, 0, At, B0); PG8_MMA(1, 1, At, B1); PG8_BAR; PG8_SCHED;
            } else {
            PG8_LDB(B0, 0, 0); PG8_SCHED; PG8_LDA(At, 0, 0); PG8_STAGE(PG8_SA(1, 1), a1 + hstep, voffA);
            PG8_WAIT_L(8); PG8_BAR; PG8_WAIT_L(0); PG8_MMA(0, 0, At, B0); PG8_BAR; PG8_SCHED;
            PG8_LDB(B1, 0, 1); PG8_STAGE(PG8_SB(0, 0), b2, voffB);
            PG8_BAR; PG8_WAIT_L(0); PG8_MMA(0, 1, At, B1); PG8_BAR;
            PG8_LDA(At, 0, 1); PG8_STAGE(PG8_SA(0, 0), a2, voffA);
            PG8_BAR; PG8_WAIT_L(0); PG8_MMA(1, 0, At, B0); PG8_BAR; PG8_SCHED;
            PG8_STAGE(PG8_SB(0, 1), b2 + hstep, voffB);
            PG8_WAIT_V(6); PG8_BAR; PG8_MMA(1, 1, At, B1); PG8_BAR;
            PG8_LDB(B0, 1, 0); PG8_SCHED; PG8_LDA(At, 1, 0); PG8_STAGE(PG8_SA(0, 1), a2 + hstep, voffA);
            PG8_WAIT_L(8); PG8_BAR; PG8_WAIT_L(0); PG8_MMA(0, 0, At, B0); PG8_BAR; PG8_SCHED;
            PG8_LDB(B1, 1, 1); PG8_STAGE(PG8_SB(1, 0), b3, voffB);
            PG8_BAR; PG8_WAIT_L(0); PG8_MMA(0, 1, At, B1); PG8_BAR;
            PG8_LDA(At, 1, 1); PG8_STAGE(PG8_SA(1, 0), a3, voffA);
            PG8_BAR; PG8_WAIT_L(0); PG8_MMA(1, 0, At, B0); PG8_BAR; PG8_SCHED;
            PG8_STAGE(PG8_SB(1, 1), b3 + hstep, voffB);
            PG8_WAIT_V(6); PG8_BAR; PG8_MMA(1, 1, At, B1); PG8_BAR;
            }
        }
        if constexpr (ALIGN_EPI) { if (wr == 0) PG8_BAR; }
        if constexpr (!Epi::AFTER_DRAIN) { E(acc, cur, wr, wc, fr, fq); S.done(cur); }
        if (!has_next) break;
#pragma unroll
        for (int a = 0; a < 2; ++a)
#pragma unroll
            for (int b = 0; b < 2; ++b)
#pragma unroll
                for (int m = 0; m < 4; ++m)
#pragma unroll
                    for (int n = 0; n < 2; ++n) acc[a][b][m][n] = (f32x4){0.f, 0.f, 0.f, 0.f};
        cur = nxt; cA = nA; cB = nB; ++ui;
        if constexpr (ALIGN_EPI) { if (wr == 1) PG8_BAR; }
    }
    PG8_WAIT_V(0);
    if constexpr (!ALIGN_EPI) { if (wr == 0) PG8_BAR; }
    PG8_BAR;
    if constexpr (Epi::AFTER_DRAIN) { E.fused(acc, cur, wr, wc, fr, fq, lds, wid, lane); S.done(cur); }
#undef PG8_SA
#undef PG8_SB
#undef PG8_STAGE
#undef PG8_LDA
#undef PG8_LDB
#undef PG8_MMA
#undef PG8_WAIT_V
#undef PG8_WAIT_L
#undef PG8_BAR
#undef PG8_SCHED
}
}

constexpr int NWAVES = 8;
constexpr int N_LAUNCHES = MK_N_LAUNCHES;
constexpr int PER_PHASE = 8;
constexpr int D = 1024, NBATCH = 8, SEQ = 2048, MP = NBATCH * SEQ, MS = 128, MROWS = 16640;
constexpr int NIN = 7424, DFF = 2816, NGU = 5632;
constexpr float RMS_EPS = 1e-6f;
constexpr float LOG2E = 1.4426950408889634f;
constexpr float C2 = 0.125f * LOG2E;

constexpr size_t MiB = 1u << 20;
constexpr size_t ACTB = (size_t)MROWS * 1024 * 2;
constexpr size_t WS_CTL = 0, CTL_ZERO_BYTES = 1 * MiB;
constexpr size_t WS_WIN = 1 * MiB;
constexpr size_t WS_Q = 16 * MiB;
constexpr size_t WS_KV = WS_Q + ACTB;
constexpr size_t WS_HQ = WS_KV + 8 * MiB + MiB / 2;
constexpr size_t WS_HF = WS_HQ + ACTB, WS_HI = WS_HF + ACTB, WS_HOG = WS_HI + ACTB, WS_GA = WS_HOG + ACTB, WS_GH = WS_GA + ACTB;
constexpr size_t WS_MISC = WS_GH + ACTB;
constexpr size_t WS_A2 = WS_HQ;
constexpr size_t WS_ACT = WS_HF;
constexpr size_t WS_WOUT = WS_GA;
constexpr size_t WS_WGU = WS_WOUT + 2 * MiB, WS_WDN = WS_WGU + 11 * MiB;
static_assert(WS_WDN + (size_t)1024 * 2816 * 2 <= WS_GH, "late weights inside GA");
static_assert(WS_ACT + (size_t)MROWS * DFF * 2 <= WS_GA, "ACT inside HF..HOG");
constexpr size_t WS_BIAS = WS_MISC;
constexpr size_t WS_SINK = WS_BIAS + 16 * 256 * 4;
constexpr size_t WS_LB = WS_SINK + 256;
constexpr size_t WS_ROWSQ = WS_MISC + 64 * 1024;
constexpr size_t WS_Y1S = WS_MISC + 512 * 1024;
constexpr size_t WS_KLS = WS_MISC + 1 * MiB;
constexpr size_t WS_EBL = WS_MISC + 1 * MiB + 512 * 1024;
constexpr size_t WS_END = WS_MISC + 3 * MiB;
static_assert(ACTB + (size_t)16384 * 1024 * 2 <= (size_t)O_KP * 4, "KLP inside d_out's y_prompt + y_sample region");
static_assert(WS_END <= 256 * MiB, "d_ws map");

constexpr int CW_TMO = 0, CW_CODE = 1, CW_BAR = 4096;

constexpr int LDS_BYTES = 147456;
constexpr int LDSCTL_OFF = LDS_BYTES - 512, MISC_OFF = LDSCTL_OFF + 320;

#define GAS __attribute__((address_space(1)))
#define LAS __attribute__((address_space(3)))
typedef unsigned short bf16;
typedef unsigned v4u __attribute__((ext_vector_type(4)));
typedef float f32x4 __attribute__((ext_vector_type(4)));
typedef short bf16x8 __attribute__((ext_vector_type(8)));
typedef GAS unsigned gu32;
#define RLX_AGENT __ATOMIC_RELAXED, __HIP_MEMORY_SCOPE_AGENT
#define LDS_WAIT() asm volatile("s_waitcnt lgkmcnt(0)" ::: "memory")
#define VM_WAIT() asm volatile("s_waitcnt vmcnt(0)" ::: "memory")
__device__ __forceinline__ unsigned f2bf(float f) { unsigned u = __builtin_bit_cast(unsigned, f); return (u + 0x7fffu + ((u >> 16) & 1u)) >> 16; }
__device__ __forceinline__ unsigned pk2(float lo, float hi) { return f2bf(lo) | (f2bf(hi) << 16); }
__device__ __forceinline__ float bf2f(unsigned short h) { return __builtin_bit_cast(float, (unsigned)h << 16); }
__device__ __forceinline__ float bflo(unsigned w) { return __builtin_bit_cast(float, w << 16); }
__device__ __forceinline__ float bfhi(unsigned w) { return __builtin_bit_cast(float, w & 0xffff0000u); }
__device__ __forceinline__ float sigmoidf_(float v) { return 1.0f / (1.0f + __expf(-v)); }
__device__ __forceinline__ float fsig(float v) { return __builtin_amdgcn_rcpf(1.0f + __builtin_amdgcn_exp2f(-1.4426950408889634f * v)); }

#define XB_TMO      128
#define XB_XCNT(j)  (256  + 64 * (j))
#define XB_XSUB(j)  (1280 + 64 * (j))
#define XB_XGEN(j)  (2304 + 64 * (j))
#define XB_TOP      3328
#define XB_TOPGEN   3392
#define XCD_BAR_WORDS 3456
#define XB_SPIN_CAP (1u << 18)
__device__ __forceinline__ unsigned xb_ld(unsigned* p)              { return __hip_atomic_load(p, __ATOMIC_RELAXED, __HIP_MEMORY_SCOPE_AGENT); }
__device__ __forceinline__ unsigned xb_add(unsigned* p, unsigned v) { return __hip_atomic_fetch_add(p, v, __ATOMIC_RELAXED, __HIP_MEMORY_SCOPE_AGENT); }
__device__ __forceinline__ unsigned xb_xcc_id() { return (unsigned)__builtin_amdgcn_s_getreg((3 << 11) | 20) & 0xFu; }
#define XB_SPIN(cond, bar) do { unsigned _sp = 0; while (cond) { __builtin_amdgcn_s_sleep(1); \
    if ((++_sp & 255u) == 0u) { if (xb_ld(&(bar)[XB_TMO])) break; if (_sp > XB_SPIN_CAP) { atomicAdd(&(bar)[XB_TMO], 1u); break; } } } } while (0)
struct XcdBarrier { unsigned* bar; unsigned x; volatile LAS unsigned* st; };
__device__ __forceinline__ XcdBarrier xcd_barrier_post(unsigned* bar, volatile LAS unsigned* st) {
    XcdBarrier b; b.bar = bar; b.x = xb_xcc_id(); b.st = st;
    if (threadIdx.x == 0) (void)xb_add(&bar[XB_XCNT(b.x)], 1u);
    return b;
}
__device__ __forceinline__ void xcd_barrier_complete(unsigned* bar, unsigned x, unsigned& nloc, unsigned& nx) {
    const unsigned G = gridDim.x * gridDim.y * gridDim.z;
    unsigned sum, cnt, mine, sp = 0u;
    for (;;) {
        sum = 0u; cnt = 0u; mine = 0u;
#pragma unroll
        for (unsigned j = 0; j < 16; ++j) { const unsigned c = xb_ld(&bar[XB_XCNT(j)]); sum += c; cnt += (c > 0u) ? 1u : 0u; mine = (j == x) ? c : mine; }
        if (sum == G) break;
        __builtin_amdgcn_s_sleep(1);
        if ((++sp & 255u) == 0u) { if (xb_ld(&bar[XB_TMO])) break; if (sp > XB_SPIN_CAP) { atomicAdd(&bar[XB_TMO], 1u); break; } }
    }
    nloc = mine > 0u ? mine : 1u; nx = cnt > 0u ? cnt : 1u;
}
__device__ __forceinline__ void xcd_barrier(const XcdBarrier& b) {
    asm volatile("s_waitcnt vmcnt(0)" ::: "memory");
    __syncthreads();
    if (threadIdx.x == 0) {
        unsigned* bar = b.bar;
        __builtin_amdgcn_s_waitcnt(0);
        unsigned nloc = b.st[0], nx = b.st[1];
        if (nloc == 0u) { xcd_barrier_complete(bar, b.x, nloc, nx); b.st[0] = nloc; b.st[1] = nx; }
        const unsigned old = xb_add(&bar[XB_XSUB(b.x)], 1u);
        const unsigned gen = old / nloc;
        if (old + 1u == (gen + 1u) * nloc) {
            __builtin_amdgcn_fence(__ATOMIC_RELEASE, "agent");
            asm volatile("s_waitcnt vmcnt(0)" ::: "memory");
            const unsigned og = xb_add(&bar[XB_TOP], 1u);
            const unsigned tg = og / nx;
            if (og + 1u == (tg + 1u) * nx) xb_add(&bar[XB_TOPGEN], 1u);
            else XB_SPIN(xb_ld(&bar[XB_TOPGEN]) == tg, bar);
            __builtin_amdgcn_fence(__ATOMIC_ACQUIRE, "agent");
            xb_add(&bar[XB_XGEN(b.x)], 1u);
            asm volatile("s_waitcnt vmcnt(0)" ::: "memory");
        } else {
            XB_SPIN(xb_ld(&bar[XB_XGEN(b.x)]) == gen, bar);
            __builtin_amdgcn_fence(__ATOMIC_ACQUIRE, "agent");
            asm volatile("s_waitcnt vmcnt(0)" ::: "memory");
        }
    }
    __syncthreads();
}

__device__ __forceinline__ float wave_sum(float v) {
#pragma unroll
    for (int o = 1; o < 64; o <<= 1) v += __shfl_xor(v, o);
    return v;
}
__device__ __forceinline__ void transpose_item(const float* W, int K, int N, bf16* WT, int k0, int src_n0, int dst_n0, LAS float* scr, int lane) {
#pragma unroll 8
    for (int i = 0; i < 32; ++i) { const int kk = 2 * i + (lane >> 5); scr[kk * 33 + (lane & 31)] = W[(size_t)(k0 + kk) * N + src_n0 + (lane & 31)]; }
    LDS_WAIT(); asm volatile("" ::: "memory");
    const int c = lane & 7;
#pragma unroll
    for (int j = 0; j < 4; ++j) { const int n = (lane >> 3) + 8 * j; const LAS float* s = scr + (8 * c) * 33 + n;
        v4u o; o.x = pk2(s[0 * 33], s[1 * 33]); o.y = pk2(s[2 * 33], s[3 * 33]); o.z = pk2(s[4 * 33], s[5 * 33]); o.w = pk2(s[6 * 33], s[7 * 33]);
        *(GAS v4u*)(WT + (size_t)(dst_n0 + n) * K + k0 + 8 * c) = o; }
    LDS_WAIT(); asm volatile("" ::: "memory");
}
__device__ __forceinline__ void rms_row_to_bf16(const float* xrow, const float* nw, bf16* orow, int lane) {
    const GAS f32x4* xr = (const GAS f32x4*)xrow + lane; const GAS f32x4* wr4 = (const GAS f32x4*)nw + lane;
    f32x4 v[4]; float s = 0.f;
#pragma unroll
    for (int j = 0; j < 4; ++j) { v[j] = xr[64 * j]; s += (v[j].x * v[j].x + v[j].y * v[j].y) + (v[j].z * v[j].z + v[j].w * v[j].w); }
    const float rstd = 1.f / sqrtf(wave_sum(s) * (1.f / D) + RMS_EPS);
    GAS unsigned long long* o8 = (GAS unsigned long long*)orow + lane;
#pragma unroll
    for (int j = 0; j < 4; ++j) { const f32x4 w = wr4[64 * j];
        o8[64 * j] = (unsigned long long)pk2(v[j].x * rstd * w.x, v[j].y * rstd * w.y) | ((unsigned long long)pk2(v[j].z * rstd * w.z, v[j].w * rstd * w.w) << 32); }
}
__device__ __forceinline__ void rms_row_f32(const float* xrow, const float* nw, float* orow, int lane) {
    const GAS f32x4* xr = (const GAS f32x4*)xrow + lane; const GAS f32x4* wr4 = (const GAS f32x4*)nw + lane;
    f32x4 v[4]; float s = 0.f;
#pragma unroll
    for (int j = 0; j < 4; ++j) { v[j] = xr[64 * j]; s += (v[j].x * v[j].x + v[j].y * v[j].y) + (v[j].z * v[j].z + v[j].w * v[j].w); }
    const float rstd = 1.f / sqrtf(wave_sum(s) * (1.f / D) + RMS_EPS);
    GAS f32x4* o4 = (GAS f32x4*)orow + lane;
#pragma unroll
    for (int j = 0; j < 4; ++j) { const f32x4 w = wr4[64 * j]; o4[64 * j] = v[j] * rstd * w; }
}
__device__ __forceinline__ int t5_bucket(int rel) {
    const int ret = rel > 0 ? 16 : 0; const int n = rel < 0 ? -rel : rel;
    int b;
    if (n < 8) b = n; else if (n < 12) b = 8; else if (n < 16) b = 9; else if (n < 23) b = 10; else if (n < 32) b = 11; else if (n < 46) b = 12; else if (n < 64) b = 13; else if (n < 91) b = 14; else b = 15;
    return ret + b;
}

struct Args { const float* in[16]; float* out; unsigned char* ws; int ph_lo, ph_hi, li, pad; };

template <int MODE>
__device__ __forceinline__ void skinny_item(int item, const bf16* A, const bf16* Bt, int K, const float* xs, float* Y1S, bf16* A2s, const float* nw, float* rowsq_s, float* outs,
                                            LAS unsigned char* lds, int wave, int lane) {
    const int rg = item >> 2, cb = item & 3; const int fr = lane & 15, fq = lane >> 4;
    const bf16* ap = A + (size_t)(rg * 16 + fr) * K + fq * 8;
    const bf16* bp0 = Bt + (size_t)(cb * 256 + wave * 32 + fr) * K + fq * 8;
    const bf16* bp1 = bp0 + (size_t)16 * K;
    f32x4 acc0 = {0.f, 0.f, 0.f, 0.f}, acc1 = {0.f, 0.f, 0.f, 0.f};
#pragma unroll 4
    for (int k = 0; k < K; k += 32) {
        const bf16x8 a = *(const bf16x8*)(ap + k), b0 = *(const bf16x8*)(bp0 + k), b1 = *(const bf16x8*)(bp1 + k);
        acc0 = __builtin_amdgcn_mfma_f32_16x16x32_bf16(a, b0, acc0, 0, 0, 0);
        acc1 = __builtin_amdgcn_mfma_f32_16x16x32_bf16(a, b1, acc1, 0, 0, 0);
    }
    LAS float* P = (LAS float*)lds;
    float ssq[4];
#pragma unroll
    for (int r = 0; r < 4; ++r) {
        const int row = rg * 16 + fq * 4 + r; const int c0 = cb * 256 + wave * 32 + fr, c1 = c0 + 16;
        if (MODE == 0) {
            const float y0 = xs[(size_t)row * 1024 + c0] + acc0[r], y1 = xs[(size_t)row * 1024 + c1] + acc1[r];
            Y1S[(size_t)row * 1024 + c0] = y0; Y1S[(size_t)row * 1024 + c1] = y1;
            A2s[(size_t)row * 1024 + c0] = (bf16)f2bf(y0 * nw[c0]); A2s[(size_t)row * 1024 + c1] = (bf16)f2bf(y1 * nw[c1]);
            ssq[r] = y0 * y0 + y1 * y1;
        } else {
            outs[(size_t)row * 1024 + c0] = Y1S[(size_t)row * 1024 + c0] + acc0[r];
            outs[(size_t)row * 1024 + c1] = Y1S[(size_t)row * 1024 + c1] + acc1[r];
            ssq[r] = 0.f;
        }
    }
    if (MODE == 0) {
#pragma unroll
        for (int r = 0; r < 4; ++r) { float s = ssq[r]; s += __shfl_xor(s, 1); s += __shfl_xor(s, 2); s += __shfl_xor(s, 4); s += __shfl_xor(s, 8); if (fr == 0) P[(fq * 4 + r) * 8 + wave] = s; }
        LDS_WAIT(); __syncthreads();
        if (wave == 0 && lane < 16) { float t = 0.f;
#pragma unroll
            for (int w = 0; w < 8; ++w) t += P[lane * 8 + w];
            rowsq_s[(size_t)(rg * 16 + lane) * 4 + cb] = t; }
        LDS_WAIT(); __syncthreads();
    }
}

typedef short v4i16_t __attribute__((ext_vector_type(4)));
typedef unsigned v2u __attribute__((ext_vector_type(2)));
__device__ __forceinline__ unsigned offb(unsigned row, unsigned ch) { return 256u * row + 16u * (ch ^ (((row & 3u) << 2) | ((row >> 2) & 3u))); }
__device__ __forceinline__ unsigned cvtpk(float lo, float hi) { unsigned r; asm volatile("v_cvt_pk_bf16_f32 %0, %1, %2" : "=v"(r) : "v"(lo), "v"(hi)); return r; }
struct HgrnItem { int row0, klrow0, nch, nvalid, ebl0; const bf16* KL; const float* S0; float* Sout; };
constexpr int HG_BUF = 65536, HG_A = 131072, HG_RED = 131072 + 8192, HG_EBL = HG_RED + 2048, HG_END = HG_EBL + 1024;
static_assert(HG_END <= LDSCTL_OFF, "HGRN LDS map");
__device__ __forceinline__ void hgrn_stage_load(v4u (&st)[8], f32x4& ste, const float* EBL, const HgrnItem& it, int c, int h, const bf16* QE, const bf16* QE2, const bf16* HI, int tid) {
    if (tid < 32) ste = *(const f32x4*)(EBL + (size_t)(it.ebl0 + c) * 1024 + h * 128 + tid * 4);
#pragma unroll
    for (int k = 0; k < 8; ++k) {
        const int within = tid + 512 * (k & 1), row = within >> 4, ch = within & 15;
        const bf16* src;
        if ((k >> 1) == 0) src = QE + (size_t)(it.row0 + 64 * c + row) * 1024;
        else if ((k >> 1) == 1) src = QE2 + (size_t)(it.row0 + 64 * c + row) * 1024;
        else if ((k >> 1) == 2) src = it.KL + (size_t)(it.klrow0 + 64 * c + row) * 1024;
        else src = HI + (size_t)(it.row0 + 64 * c + row) * 1024;
        if (row < it.nvalid) st[k] = *(const v4u*)(src + h * 128 + ch * 8); else st[k] = (v4u){0u, 0u, 0u, 0u};
    }
}
__device__ __forceinline__ void hgrn_stage_write(const v4u (&st)[8], const f32x4& ste, LAS unsigned char* ebuf, LAS unsigned char* buf, int tid) {
    if (tid < 32) *(LAS f32x4*)(ebuf + tid * 16) = ste;
#pragma unroll
    for (int k = 0; k < 8; ++k) { const int within = tid + 512 * (k & 1), row = within >> 4, ch = within & 15; *(LAS v4u*)(buf + (k >> 1) * 16384 + offb(row, ch)) = st[k]; }
}
__device__ __forceinline__ void hgrn_item(LAS unsigned char* L, const HgrnItem it, int h, const bf16* QE, const bf16* QE2, const bf16* HI, const bf16* HOG, const bf16* GH, bf16* MERGED,
                                          const float* EBL, const float* gnorm, int tid, int wave, int lane, bool do_store) {
    const int r16_ = lane & 15, q4_ = lane >> 4, w = wave;
    f32x4 S[8];
    { const int r16 = r16_, q4 = q4_;
#pragma unroll
    for (int i = 0; i < 8; ++i)
#pragma unroll
        for (int r = 0; r < 4; ++r) S[i][r] = it.S0 ? it.S0[(size_t)(16 * i + 4 * q4 + r) * 128 + 16 * w + r16] : 0.f;
    }
    float gnv[8];
#pragma unroll
    for (int e2 = 0; e2 < 8; ++e2) gnv[e2] = gnorm[(tid & 15) * 8 + e2];
    v4u st[8]; f32x4 ste = {0.f, 0.f, 0.f, 0.f};
    hgrn_stage_load(st, ste, EBL, it, 0, h, QE, QE2, HI, tid);
    hgrn_stage_write(st, ste, L + HG_EBL, L, tid);
    LDS_WAIT(); __syncthreads();
    constexpr int HREP = ((PROBE_MASK >> 3) & 1) ? 2 : 1;
    for (int cc = 0; cc < it.nch * HREP; ++cc) {
        const int c = (HREP == 1) ? cc : (cc % it.nch);
        int r16 = r16_, q4 = q4_; asm volatile("" : "+v"(r16), "+v"(q4));
        const int tq = r16 >> 2, tp = r16 & 3;
        if (HREP == 2) do_store = cc < it.nch;
        LAS unsigned char* B = L + (cc & 1) * HG_BUF;
        LAS unsigned char* QEt = B; LAS unsigned char* Q2t = B + 16384; LAS unsigned char* KLt = B + 32768; LAS unsigned char* Vt = B + 49152;
        if (cc + 1 < it.nch * HREP) hgrn_stage_load(st, ste, EBL, it, (HREP == 1) ? c + 1 : ((cc + 1) % it.nch), h, QE, QE2, HI, tid);
        v4u pf[2][3];
#pragma unroll
        for (int k = 0; k < 2; ++k) { const int within = tid + 512 * k, t = within >> 4, gc = within & 15;
            if (t < it.nvalid) { const size_t gi = (size_t)(it.row0 + 64 * c + t) * 1024 + h * 128 + gc * 8;
                pf[k][0] = *(const v4u*)(HOG + gi); pf[k][1] = *(const v4u*)(GH + gi); pf[k][2] = *(const v4u*)(MERGED + gi); }
            else { pf[k][0] = (v4u){0u, 0u, 0u, 0u}; pf[k][1] = pf[k][0]; pf[k][2] = pf[k][0]; } }
        f32x4 o[4];
#pragma unroll
        for (int tt = 0; tt < 4; ++tt) o[tt] = (f32x4){0.f, 0.f, 0.f, 0.f};
        {
            bf16x8 Sb[4];
#pragma unroll
            for (int s4 = 0; s4 < 4; ++s4) { v4u wv; wv.x = cvtpk(S[2 * s4][0], S[2 * s4][1]); wv.y = cvtpk(S[2 * s4][2], S[2 * s4][3]); wv.z = cvtpk(S[2 * s4 + 1][0], S[2 * s4 + 1][1]); wv.w = cvtpk(S[2 * s4 + 1][2], S[2 * s4 + 1][3]);
                Sb[s4] = __builtin_bit_cast(bf16x8, wv); }
#pragma unroll
            for (int tt = 0; tt < 4; ++tt) { const unsigned t = 16 * tt + r16;
#pragma unroll
                for (int s4 = 0; s4 < 4; ++s4) {
                    const v2u lo = *(const LAS v2u*)(QEt + offb(t, 4 * s4 + (q4 >> 1)) + 8 * (q4 & 1));
                    const v2u hi = *(const LAS v2u*)(QEt + offb(t, 4 * s4 + 2 + (q4 >> 1)) + 8 * (q4 & 1));
                    const v4u av = {lo.x, lo.y, hi.x, hi.y};
                    o[tt] = __builtin_amdgcn_mfma_f32_16x16x32_bf16(__builtin_bit_cast(bf16x8, av), Sb[s4], o[tt], 0, 0, 0);
                } }
        }
#pragma unroll
        for (int k2 = 0; k2 < 2; ++k2) {
            const int idx = 2 * w + k2, sb = idx >> 2, tb = idx & 3;
            f32x4 cacc = {0.f, 0.f, 0.f, 0.f};
            if (tb >= sb) {
#pragma unroll
                for (int ks = 0; ks < 4; ++ks) {
                    const bf16x8 a = *(const LAS bf16x8*)(KLt + offb(16 * sb + r16, 4 * ks + q4));
                    const bf16x8 bq = *(const LAS bf16x8*)(Q2t + offb(16 * tb + r16, 4 * ks + q4));
                    cacc = __builtin_amdgcn_mfma_f32_16x16x32_bf16(a, bq, cacc, 0, 0, 0);
                }
            }
            const int tval = 16 * tb + r16, s0 = 16 * sb + 4 * q4;
            float v[4];
#pragma unroll
            for (int r = 0; r < 4; ++r) v[r] = (tval >= s0 + r) ? cacc[r] : 0.f;
            v2u wv; wv.x = cvtpk(v[0], v[1]); wv.y = cvtpk(v[2], v[3]);
            *(LAS v2u*)(L + HG_A + tval * 128 + (((s0 >> 3) ^ ((tval >> 1) & 7)) << 4) + (s0 & 7) * 2) = wv;
        }
        LDS_WAIT(); __syncthreads();
        bf16x8 Vf[2];
#pragma unroll
        for (int s2 = 0; s2 < 2; ++s2) {
            const v4i16_t lo = __builtin_amdgcn_ds_read_tr16_b64_v4i16((LAS v4i16_t*)(Vt + offb(32 * s2 + 8 * q4 + tq, 2 * w + (tp >> 1)) + 8 * (tp & 1)));
            const v4i16_t hi = __builtin_amdgcn_ds_read_tr16_b64_v4i16((LAS v4i16_t*)(Vt + offb(32 * s2 + 8 * q4 + 4 + tq, 2 * w + (tp >> 1)) + 8 * (tp & 1)));
            Vf[s2] = (bf16x8){lo[0], lo[1], lo[2], lo[3], hi[0], hi[1], hi[2], hi[3]};
        }
#pragma unroll
        for (int tt = 0; tt < 4; ++tt) { const unsigned t = 16 * tt + r16;
#pragma unroll
            for (int s2 = 0; s2 < 2; ++s2) if (s2 == 0 || tt >= 2) {
                const bf16x8 a = *(const LAS bf16x8*)(L + HG_A + t * 128 + (((4 * s2 + q4) ^ ((t >> 1) & 7)) << 4));
                o[tt] = __builtin_amdgcn_mfma_f32_16x16x32_bf16(a, Vf[s2], o[tt], 0, 0, 0);
            } }
        {
#pragma unroll
            for (int i = 0; i < 8; ++i) {
                S[i] = S[i] * *(const LAS f32x4*)(L + HG_EBL + (cc & 1) * 512 + (16 * i + 4 * q4) * 4);
#pragma unroll
                for (int s2 = 0; s2 < 2; ++s2) {
                    const v4i16_t lo = __builtin_amdgcn_ds_read_tr16_b64_v4i16((LAS v4i16_t*)(KLt + offb(32 * s2 + 8 * q4 + tq, 2 * i + (tp >> 1)) + 8 * (tp & 1)));
                    const v4i16_t hi = __builtin_amdgcn_ds_read_tr16_b64_v4i16((LAS v4i16_t*)(KLt + offb(32 * s2 + 8 * q4 + 4 + tq, 2 * i + (tp >> 1)) + 8 * (tp & 1)));
                    const bf16x8 a = (bf16x8){lo[0], lo[1], lo[2], lo[3], hi[0], hi[1], hi[2], hi[3]};
                    S[i] = __builtin_amdgcn_mfma_f32_16x16x32_bf16(a, Vf[s2], S[i], 0, 0, 0);
                }
            }
        }
        LAS float* RED = (LAS float*)(L + HG_RED);
        LAS float* OT = (LAS float*)B;
#pragma unroll
        for (int tt = 0; tt < 4; ++tt)
#pragma unroll
            for (int r = 0; r < 4; ++r) { const int t = 16 * tt + 4 * q4 + r; const float ov = o[tt][r];
                OT[t * 128 + 16 * w + r16] = ov;
                float ss = ov * ov; ss += __shfl_xor(ss, 1); ss += __shfl_xor(ss, 2); ss += __shfl_xor(ss, 4); ss += __shfl_xor(ss, 8);
                if (r16 == 0) RED[t * 8 + w] = ss; }
        LDS_WAIT(); __syncthreads();
#pragma unroll
        for (int k = 0; k < 2; ++k) { const int within = tid + 512 * k, t = within >> 4, gc = within & 15;
            if (t < it.nvalid) {
                const f32x4 r0 = *(const LAS f32x4*)(RED + t * 8), r1 = *(const LAS f32x4*)(RED + t * 8 + 4);
                const float tot = ((r0[0] + r0[1]) + (r0[2] + r0[3])) + ((r1[0] + r1[1]) + (r1[2] + r1[3]));
                const float rstd = 1.0f / sqrtf(tot * (1.0f / 128.0f) + RMS_EPS);
                const f32x4 o0 = *(const LAS f32x4*)(OT + t * 128 + gc * 8), o1 = *(const LAS f32x4*)(OT + t * 128 + gc * 8 + 4);
                const float ov[8] = {o0[0], o0[1], o0[2], o0[3], o1[0], o1[1], o1[2], o1[3]};
                const unsigned hw[4] = {pf[k][0].x, pf[k][0].y, pf[k][0].z, pf[k][0].w}, gw_[4] = {pf[k][1].x, pf[k][1].y, pf[k][1].z, pf[k][1].w}, aw[4] = {pf[k][2].x, pf[k][2].y, pf[k][2].z, pf[k][2].w};
                float res[8];
#pragma unroll
                for (int e2 = 0; e2 < 4; ++e2) {
                    const float og0 = bflo(hw[e2]), og1 = bfhi(hw[e2]), gh0 = bflo(gw_[e2]), gh1 = bfhi(gw_[e2]);
                    res[2 * e2] = bflo(aw[e2]) + fsig(gh0) * (ov[2 * e2] * rstd * gnv[2 * e2] * (og0 * fsig(og0)));
                    res[2 * e2 + 1] = bfhi(aw[e2]) + fsig(gh1) * (ov[2 * e2 + 1] * rstd * gnv[2 * e2 + 1] * (og1 * fsig(og1)));
                }
                v4u wv; wv.x = pk2(res[0], res[1]); wv.y = pk2(res[2], res[3]); wv.z = pk2(res[4], res[5]); wv.w = pk2(res[6], res[7]);
                if (do_store) *(v4u*)(MERGED + (size_t)(it.row0 + 64 * c + t) * 1024 + h * 128 + gc * 8) = wv;
            } }
        if (cc + 1 < it.nch * HREP) hgrn_stage_write(st, ste, L + HG_EBL + ((cc + 1) & 1) * 512, L + ((cc + 1) & 1) * HG_BUF, tid);
        if (HREP == 2 && cc == it.nch - 1) {
#pragma unroll
            for (int i = 0; i < 8; ++i)
#pragma unroll
                for (int r = 0; r < 4; ++r) it.Sout[(size_t)(16 * i + 4 * q4 + r) * 128 + 16 * w + r16] = S[i][r]; }
        LDS_WAIT(); __syncthreads();
    }
#pragma unroll
    for (int i = 0; i < 8; ++i)
#pragma unroll
        for (int r = 0; r < 4; ++r) { if (do_store || S[i][r] == 1234.5678f) it.Sout[(size_t)(16 * i + 4 * q4_ + r) * 128 + 16 * w + r16_] = S[i][r]; }
}

typedef float f32x16 __attribute__((ext_vector_type(16)));
constexpr int AT_K = 0, AT_V = 24576, AT_B = 49152, AT_W = 57344, AT_O = 59392, AT_END = 59392 + 65536, AT_CH = 3072, AT_DH = 12288;
static_assert(AT_END <= LDSCTL_OFF, "attention LDS map");
__device__ __forceinline__ int crow16(int r, int hi) { return (r & 3) + 8 * (r >> 2) + 4 * hi; }
__device__ __forceinline__ void attn_unit(LAS unsigned char* L, int unit, const bf16* QB_, const bf16* KVB, const bf16* GAB, bf16* AG, const float* cache_k, const float* cache_v,
                                          const float* BIAS2, const float* SINK2, int tid, int wave, int lane, bool do_store, float* sinkhole) {
    const bool samp = unit >= 512;
    int b, kvh, qrow0, kt0, nks, nqb;
    if (!samp) { b = unit >> 6; const int c = (unit >> 1) & 31; kvh = unit & 1; qrow0 = b * SEQ + c * 64; kt0 = c >= 2 ? 0 : (2 - c) * 2; nks = 12; nqb = 2; }
    else { const int us = unit - 512; b = us >> 1; kvh = us & 1; qrow0 = MP + b * 16; kt0 = 0; nks = 9; nqb = 1; }
    __syncthreads();
    for (int i = tid; i < nks * 16 * 8; i += 512) {
        const int j = i >> 3, ch = i & 7;
        if (j < kt0 * 32) continue;
        v4u kw, vw;
        if (samp && j < 128) {
            const float* kp = cache_k + ((size_t)(b * 128 + j) * 128 + kvh * 64 + ch * 8); const float* vp = cache_v + ((size_t)(b * 128 + j) * 128 + kvh * 64 + ch * 8);
            const f32x4 k0 = *(const f32x4*)kp, k1 = *(const f32x4*)(kp + 4), v0 = *(const f32x4*)vp, v1 = *(const f32x4*)(vp + 4);
            kw.x = pk2(k0[0], k0[1]); kw.y = pk2(k0[2], k0[3]); kw.z = pk2(k1[0], k1[1]); kw.w = pk2(k1[2], k1[3]);
            vw.x = pk2(v0[0], v0[1]); vw.y = pk2(v0[2], v0[3]); vw.z = pk2(v1[0], v1[1]); vw.w = pk2(v1[2], v1[3]);
        } else {
            const size_t row = samp ? (size_t)(MP + b * 16 + (j - 128)) : (size_t)(qrow0 - 128 + j);
            kw = *(const v4u*)(KVB + row * 256 + kvh * 64 + ch * 8); vw = *(const v4u*)(KVB + row * 256 + 128 + kvh * 64 + ch * 8);
        }
        *(LAS v4u*)(L + AT_K + ch * AT_CH + j * 16) = kw;
        *(LAS v4u*)(L + AT_V + (ch >> 2) * AT_DH + j * 64 + (ch & 3) * 16) = vw;
    }
    for (int i = tid; i < 8 * 256; i += 512) ((LAS float*)(L + AT_B))[i] = BIAS2[(kvh * 8 + (i >> 8)) * 256 + (i & 255)];
    LDS_WAIT(); __syncthreads();
    const int r32 = lane & 31, hi = lane >> 5, g = wave, h16 = kvh * 8 + g;
    const float sk = SINK2[h16];
    LAS float* wsf = (LAS float*)(L + AT_W) + g * 64;
    const LAS float* bs = (const LAS float*)(L + AT_B) + g * 256;
    const LAS unsigned char* kb = L + AT_K + hi * AT_CH + r32 * 16;
    const LAS unsigned char* vb = L + AT_V + ((lane >> 4) & 1) * 32 + (lane & 3) * 8 + (4 * hi + ((lane & 15) >> 2)) * 64;
    for (int qb = 0; qb < nqb; ++qb) {
        const int qloc = qb * 32 + r32;
        const size_t qrow = (size_t)qrow0 + (samp ? (qloc & 15) : qloc);
        bf16x8 qr[4];
#pragma unroll
        for (int d0 = 0; d0 < 4; ++d0) qr[d0] = *(const bf16x8*)(QB_ + qrow * 1024 + h16 * 64 + d0 * 16 + hi * 8);
        v4u gaf[4];
#pragma unroll
        for (int k = 0; k < 4; ++k) { const int ql = k * 8 + (lane >> 3), gc = lane & 7;
            gaf[k] = (!samp || ql < 16) ? *(const v4u*)(GAB + ((size_t)qrow0 + qb * 32 + ql) * 1024 + h16 * 64 + gc * 8) : (v4u){0u, 0u, 0u, 0u}; }
        f32x16 p[6];
#pragma unroll
        for (int kt = 0; kt < 6; ++kt) {
            if (kt >= kt0 && 2 * kt < nks) {
#pragma unroll
                for (int r = 0; r < 16; ++r) p[kt][r] = bs[kt * 32 + crow16(r, hi) - qloc + 63];
#pragma unroll
                for (int d0 = 0; d0 < 4; ++d0) {
                    const bf16x8 kf = *(const LAS bf16x8*)(kb + (2 * d0) * AT_CH + kt * 512);
                    p[kt] = __builtin_amdgcn_mfma_f32_32x32x16_bf16(kf, qr[d0], p[kt], 0, 0, 0);
                }
                if (2 * kt + 1 >= nks) {
#pragma unroll
                    for (int r = 8; r < 16; ++r) p[kt][r] = -1e30f;
                }
            }
        }
        float mx = sk;
#pragma unroll
        for (int kt = 0; kt < 6; ++kt) if (kt >= kt0 && 2 * kt < nks) {
#pragma unroll
            for (int r = 0; r < 16; ++r) mx = fmaxf(mx, p[kt][r]); }
        mx = fmaxf(mx, __shfl_xor(mx, 32));
        float l = 0.f;
#pragma unroll
        for (int kt = 0; kt < 6; ++kt) if (kt >= kt0 && 2 * kt < nks) {
#pragma unroll
            for (int r = 0; r < 16; ++r) { const float e = __builtin_amdgcn_exp2f(p[kt][r] - mx); p[kt][r] = e; l += e; } }
        l += __shfl_xor(l, 32);
        l += __builtin_amdgcn_exp2f(sk - mx);
        f32x16 o[2];
#pragma unroll
        for (int r = 0; r < 16; ++r) { o[0][r] = 0.f; o[1][r] = 0.f; }
#pragma unroll
        for (int kt = 0; kt < 6; ++kt) if (kt >= kt0 && 2 * kt < nks) {
#pragma unroll
            for (int s2 = 0; s2 < 2; ++s2) if (2 * kt + s2 < nks) {
                v4u pw; pw.x = cvtpk(p[kt][8 * s2 + 0], p[kt][8 * s2 + 1]); pw.y = cvtpk(p[kt][8 * s2 + 2], p[kt][8 * s2 + 3]); pw.z = cvtpk(p[kt][8 * s2 + 4], p[kt][8 * s2 + 5]); pw.w = cvtpk(p[kt][8 * s2 + 6], p[kt][8 * s2 + 7]);
                const bf16x8 pa = __builtin_bit_cast(bf16x8, pw);
#pragma unroll
                for (int d0 = 0; d0 < 2; ++d0) {
                    const LAS unsigned char* va = vb + d0 * AT_DH + (2 * kt + s2) * 1024;
                    const v4i16_t lo = __builtin_amdgcn_ds_read_tr16_b64_v4i16((LAS v4i16_t*)va);
                    const v4i16_t hv = __builtin_amdgcn_ds_read_tr16_b64_v4i16((LAS v4i16_t*)(va + 512));
                    const bf16x8 vf = (bf16x8){lo[0], lo[1], lo[2], lo[3], hv[0], hv[1], hv[2], hv[3]};
                    o[d0] = __builtin_amdgcn_mfma_f32_32x32x16_bf16(pa, vf, o[d0], 0, 0, 0);
                }
            } }
        if (hi == 0) wsf[r32] = l;
        LDS_WAIT();
        LAS float* ost = (LAS float*)(L + AT_O) + g * 2048;
#pragma unroll
        for (int r = 0; r < 16; ++r) { const float rl = __builtin_amdgcn_rcpf(wsf[crow16(r, hi)]);
            ost[crow16(r, hi) * 64 + r32] = o[0][r] * rl; ost[crow16(r, hi) * 64 + 32 + r32] = o[1][r] * rl; }
        LDS_WAIT();
#pragma unroll
        for (int k = 0; k < 4; ++k) { const int ql = k * 8 + (lane >> 3), gc = lane & 7;
            if (!samp || ql < 16) {
                const f32x4 o0 = *(const LAS f32x4*)(ost + ql * 64 + gc * 8), o1 = *(const LAS f32x4*)(ost + ql * 64 + gc * 8 + 4);
                const unsigned gws[4] = {gaf[k].x, gaf[k].y, gaf[k].z, gaf[k].w};
                v4u wv;
                wv.x = pk2(o0[0] * fsig(bflo(gws[0])), o0[1] * fsig(bfhi(gws[0]))); wv.y = pk2(o0[2] * fsig(bflo(gws[1])), o0[3] * fsig(bfhi(gws[1])));
                wv.z = pk2(o1[0] * fsig(bflo(gws[2])), o1[1] * fsig(bfhi(gws[2]))); wv.w = pk2(o1[2] * fsig(bflo(gws[3])), o1[3] * fsig(bfhi(gws[3])));
                if (do_store) *(v4u*)(AG + ((size_t)qrow0 + qb * 32 + ql) * 1024 + h16 * 64 + gc * 8) = wv; else if (wv.x == 0x12345678u) *sinkhole = 1.f;
            } }
        LDS_WAIT();
    }
}

__global__ void __launch_bounds__(NWAVES * 64, 2) mk_fwd(Args args) {
    extern __shared__ __attribute__((aligned(16))) unsigned char lds[];
    LAS unsigned char* L = (LAS unsigned char*)lds;
    volatile LAS unsigned* MISC = (volatile LAS unsigned*)(L + MISC_OFF);
    const int tid = threadIdx.x, lane = tid & 63, wave = __builtin_amdgcn_readfirstlane(tid >> 6);
    const int G = gridDim.x; const int bx = blockIdx.x;
    const int vcu = (G % 8 == 0) ? (bx % 8) * (G / 8) + bx / 8 : bx;
    unsigned char* ws = args.ws;
    gu32* ctl = (gu32*)(ws + WS_CTL);
    const float* x_prompt = args.in[0]; const float* x_sample = args.in[1]; const float* cache_k = args.in[2]; const float* cache_v = args.in[3];
    const float* state_in = args.in[4]; const float* norm_mix = args.in[5]; const float* w_in = args.in[6]; const float* w_out = args.in[7];
    const float* sinks = args.in[8]; const float* rel_tab = args.in[9]; const float* hgrn_lb = args.in[10]; const float* hgrn_norm = args.in[11];
    const float* norm_ffn = args.in[12]; const float* w_gu = args.in[13]; const float* w_dn = args.in[14]; const float* norm_final = args.in[15];
    float* out = args.out;
    bf16* WinT = (bf16*)(ws + WS_WIN); bf16* WoutT = (bf16*)(ws + WS_WOUT); bf16* WguT = (bf16*)(ws + WS_WGU); bf16* WdnT = (bf16*)(ws + WS_WDN);
    bf16* QB = (bf16*)(ws + WS_Q); bf16* KVB = (bf16*)(ws + WS_KV); bf16* HQB = (bf16*)(ws + WS_HQ); bf16* HFB = (bf16*)(ws + WS_HF); bf16* HIB = (bf16*)(ws + WS_HI);
    bf16* HOGB = (bf16*)(ws + WS_HOG); bf16* GAB = (bf16*)(ws + WS_GA); bf16* GHB = (bf16*)(ws + WS_GH);
    bf16* A2B = (bf16*)(ws + WS_A2); bf16* ACTB_ = (bf16*)(ws + WS_ACT);
    bf16* XN = (bf16*)out;
    float* BIAS2 = (float*)(ws + WS_BIAS); float* SINK2 = (float*)(ws + WS_SINK); float* LBV = (float*)(ws + WS_LB);
    float* ROWSQ = (float*)(ws + WS_ROWSQ); float* Y1S = (float*)(ws + WS_Y1S);
    bf16* KLP = (bf16*)((unsigned char*)out + ACTB); bf16* KLS = (bf16*)(ws + WS_KLS); float* EBL = (float*)(ws + WS_EBL);

    for (int u = tid; u < (LDS_BYTES - LDSCTL_OFF) / 4; u += NWAVES * 64) ((LAS unsigned*)(L + LDSCTL_OFF))[u] = 0u;
    __syncthreads();
    XcdBarrier bar; bar.bar = (unsigned*)(ctl + CW_BAR); bar.x = 0; bar.st = nullptr;
    if (N_LAUNCHES != PER_PHASE) bar = xcd_barrier_post((unsigned*)(ctl + CW_BAR), MISC + 8);
#define GRID_BAR() do { if (N_LAUNCHES != PER_PHASE) { xcd_barrier(bar); } } while (0)
    const int lo = args.ph_lo, hi = args.ph_hi; const int probe = args.pad;
#define IN(k) (lo <= (k) && (k) < hi)
#define BOTH(k) (IN(k) && IN((k) + 1))
    const int gw = vcu * NWAVES + wave, NGW = G * NWAVES;

    if (IN(0)) {
        LAS float* scr = (LAS float*)(L + wave * 16384);
        constexpr int I_IN = (D / 64) * (NIN / 32);
        for (int it = gw; it < I_IN; it += NGW) { const int nblk = NIN / 32, kb = it / nblk, nb = it % nblk; const int n0 = 32 * nb;
            int src = n0;
            if (n0 >= 1280 && n0 < 3328) { const int r = n0 - 1280; src = (((r >> 7) & 1) ? 2304 : 1280) + (r >> 8) * 128 + (r & 127); }
            transpose_item(w_in, D, NIN, WinT, 64 * kb, src, n0, scr, lane); }
        for (int m = gw; m < MROWS; m += NGW) {
            if (m < MP) rms_row_to_bf16(x_prompt + (size_t)m * D, norm_mix, XN + (size_t)m * D, lane);
            else if (m < MP + MS) rms_row_to_bf16(x_sample + (size_t)(m - MP) * D, norm_mix, XN + (size_t)m * D, lane);
            else { GAS unsigned long long* o8 = (GAS unsigned long long*)(XN + (size_t)m * D) + lane;
#pragma unroll
                for (int j = 0; j < 4; ++j) o8[64 * j] = 0ull; }
        }
        const int gt = vcu * (NWAVES * 64) + tid, NGT = G * NWAVES * 64;
        for (int i = gt; i < 16 * 256; i += NGT) { const int h = i >> 8, idx = i & 255; const int rel = idx - 191; BIAS2[i] = (idx < 255) ? rel_tab[t5_bucket(rel) * 16 + h] * LOG2E : 0.f; }
        for (int i = gt; i < 16; i += NGT) SINK2[i] = sinks[i] * LOG2E;
        for (int i = gt; i < 1024; i += NGT) LBV[i] = 1.0f / (1.0f + __expf(hgrn_lb[1024 + i] - hgrn_lb[i]));
        for (int i = gt; i < 8 * 112 * 32; i += NGT) {
            const int b = i / (112 * 32), r = i % (112 * 32), j = r >> 5, c4 = r & 31;
            const f32x4 kv = *(const f32x4*)(cache_k + ((size_t)(b * 128 + 16 + j) * 128 + c4 * 4));
            const f32x4 vv = *(const f32x4*)(cache_v + ((size_t)(b * 128 + 16 + j) * 128 + c4 * 4));
            *(f32x4*)(out + O_KS + ((size_t)(b * 128 + j) * 128 + c4 * 4)) = kv;
            *(f32x4*)(out + O_VS + ((size_t)(b * 128 + j) * 128 + c4 * 4)) = vv;
        }
        for (int i = gt; i < MROWS * 4; i += NGT) ROWSQ[i] = 0.f;
        if (BOTH(0)) GRID_BAR();
    }

    if (IN(1)) {
        pg8::Gemm g{XN, WinT, MROWS, NIN, D}; pg8::StaticOrder S; S.init(MROWS, NIN, G, bx);
        pg8::EpiProj E{QB, KVB, HQB, ACTB / 2, out, C2, HQB, HFB, KLP, KLS, EBL, LBV};
        pg8::gemm_phase<pg8::EpiProj, pg8::StaticOrder, true, true>(L, g, S, E);
        if constexpr ((PROBE_MASK >> 1) & 1) pg8::gemm_phase<pg8::EpiProj, pg8::StaticOrder, true, true>(L, g, S, E);
        if (BOTH(1)) GRID_BAR();
    }

    if (IN(2)) {
        for (int unit = vcu; unit < 512 + 16; unit += G) attn_unit(L, unit, QB, KVB, GAB, QB, cache_k, cache_v, BIAS2, SINK2, tid, wave, lane, true, Y1S);
        if constexpr ((PROBE_MASK >> 2) & 1) for (int unit = vcu; unit < 512 + 16; unit += G) attn_unit(L, unit, QB, KVB, GAB, QB, cache_k, cache_v, BIAS2, SINK2, tid, wave, lane, probe == 12345, Y1S);
        if (BOTH(2)) GRID_BAR();
    }

    if (IN(3)) {
        {
            LAS float* scr = (LAS float*)(L + wave * 16384);
            constexpr int I_O = (D / 64) * (D / 32), I_GU = (D / 64) * (NGU / 32), I_DN = (DFF / 64) * (D / 32);
            const int cw = ((vcu & 3) == 0) ? -1 : ((vcu >> 2) * 3 + (vcu & 3) - 1) * NWAVES + wave, NCW = (G / 4) * 3 * NWAVES;
            for (int it = cw; it >= 0 && it < I_O + I_GU + I_DN; it += NCW) {
                int r = it;
                if (r < I_O) { const int nblk = D / 32, kb = r / nblk, nb = r % nblk; transpose_item(w_out, D, D, WoutT, 64 * kb, 32 * nb, 32 * nb, scr, lane); continue; } r -= I_O;
                if (r < I_GU) { const int nblk = NGU / 32, kb = r / nblk, nb = r % nblk; const int n0 = 32 * nb;
                    const int src = ((n0 >> 7) & 1) * DFF + (n0 >> 8) * 128 + (n0 & 127);
                    transpose_item(w_gu, D, NGU, WguT, 64 * kb, src, n0, scr, lane); continue; } r -= I_GU;
                { const int nblk = D / 32, kb = r / nblk, nb = r % nblk; transpose_item(w_dn, DFF, D, WdnT, 64 * kb, 32 * nb, 32 * nb, scr, lane); }
            }
            __syncthreads();
        }
        if ((vcu & 3) == 0) {
            const int item = vcu >> 2, sb = item >> 3, h = item & 7;
            HgrnItem ip{sb * SEQ, sb * SEQ, SEQ / 64, 64, sb * 32, KLP, nullptr, out + O_SP + (size_t)(sb * 8 + h) * 128 * 128};
            hgrn_item(L, ip, h, HQB, HFB, HIB, HOGB, GHB, QB, EBL, hgrn_norm, tid, wave, lane, true);
            HgrnItem is{MP + sb * 16, sb * 16, 1, 16, 256 + sb, KLS, state_in + (size_t)(sb * 8 + h) * 128 * 128, out + O_SS + (size_t)(sb * 8 + h) * 128 * 128};
            hgrn_item(L, is, h, HQB, HFB, HIB, HOGB, GHB, QB, EBL, hgrn_norm, tid, wave, lane, true);
        }
        if (BOTH(3)) GRID_BAR();
    }

    if (IN(4)) {
        if (vcu < 32) skinny_item<0>(vcu, QB + (size_t)MP * 1024, WoutT, D, x_sample, Y1S, A2B + (size_t)MP * 1024, norm_ffn, ROWSQ + (size_t)MP * 4, nullptr, L, wave, lane);
        __syncthreads();
        pg8::Gemm g{QB, WoutT, MP, D, D}; pg8::StaticOrder S; S.init(MP, D, G, bx);
        pg8::EpiOut E{x_prompt, out, A2B, norm_ffn, ROWSQ};
        pg8::gemm_phase<pg8::EpiOut, pg8::StaticOrder, false, true>(L, g, S, E);
        if constexpr ((PROBE_MASK >> 4) & 1) pg8::gemm_phase<pg8::EpiOut, pg8::StaticOrder, false, true>(L, g, S, E);
        if (BOTH(4)) GRID_BAR();
    }

    if (IN(5)) {
        pg8::Gemm g{A2B, WguT, MROWS, NGU, D}; pg8::StaticOrder S; S.init(MROWS, NGU, G, bx);
        pg8::EpiGU E{ACTB_, ROWSQ};
        pg8::gemm_phase<pg8::EpiGU, pg8::StaticOrder, true, true>(L, g, S, E);
        if constexpr ((PROBE_MASK >> 5) & 1) pg8::gemm_phase<pg8::EpiGU, pg8::StaticOrder, true, true>(L, g, S, E);
        if (BOTH(5)) GRID_BAR();
    }

    if (IN(6)) {
        if (vcu < 32) skinny_item<1>(vcu, ACTB_ + (size_t)MP * DFF, WdnT, DFF, nullptr, Y1S, nullptr, nullptr, nullptr, out + O_YS, L, wave, lane);
        __syncthreads();
        pg8::Gemm g{ACTB_, WdnT, MP, D, DFF}; pg8::StaticOrder S; S.init(MP, D, G, bx);
        pg8::EpiDown E{out};
        pg8::gemm_phase<pg8::EpiDown, pg8::StaticOrder, false, true>(L, g, S, E);
        if (BOTH(6)) GRID_BAR();
    }

    if (IN(7)) {
        for (int m = gw; m < MP + MS; m += NGW) { float* r = (m < MP) ? out + (size_t)m * D : out + O_YS + (size_t)(m - MP) * D; rms_row_f32(r, norm_final, r, lane); }
    }
#undef IN
#undef BOTH
}

extern "C" void kernel_launch(void* const* d_in, const int* in_sizes, int n_in, void* d_out, int out_size, void* d_ws, size_t ws_size, hipStream_t stream) {
    if (n_in != 16 || ws_size < WS_END) { fprintf(stderr, "kernel_launch: unexpected n_in %d / ws_size %zu\n", n_in, ws_size); return; }
    (void)hipFuncSetAttribute((const void*)mk_fwd, hipFuncAttributeMaxDynamicSharedMemorySize, LDS_BYTES);
    const int grid = 256;
    (void)hipMemsetAsync((char*)d_ws + WS_CTL, 0, CTL_ZERO_BYTES, stream);
    Args a{};
    for (int i = 0; i < 16; ++i) a.in[i] = (const float*)d_in[i];
    a.out = (float*)d_out; a.ws = (unsigned char*)d_ws; a.pad = PROBE_MASK;
    if (N_LAUNCHES == 1) {
        a.ph_lo = 0; a.ph_hi = PER_PHASE; a.li = 0;
        hipLaunchKernelGGL(mk_fwd, dim3(grid), dim3(NWAVES * 64), LDS_BYTES, stream, a);
    } else {
        for (int li = 0; li < PER_PHASE; ++li) { a.ph_lo = li; a.ph_hi = li + 1; a.li = li;
            hipLaunchKernelGGL(mk_fwd, dim3(grid), dim3(NWAVES * 64), LDS_BYTES, stream, a); }
    }
}
```

```cpp
#include <hip/hip_runtime.h>
#include <cstdio>
#include <cstdint>

#ifndef PROBE_MASK
#define PROBE_MASK 0
#endif
#ifndef MK_N_LAUNCHES
#define MK_N_LAUNCHES 1
#endif

constexpr int O_YP = 0, O_YS = 16777216, O_KP = 16908288, O_VP = 17039360, O_SP = 17170432, O_KS = 18219008, O_VS = 18350080, O_SS = 18481152;
namespace pg8 {
#define PG8_LAS __attribute__((address_space(3)))
typedef unsigned short bf16_t;
typedef short bf16x8 __attribute__((ext_vector_type(8)));
typedef float f32x4 __attribute__((ext_vector_type(4)));
typedef unsigned u32x4 __attribute__((ext_vector_type(4)));
constexpr int BM = 256, BK = 64, HALF = 128, HTB = HALF * BK * 2, STAGE_BYTES = 8 * HTB, NXCD = 8, WGM = 8;

__host__ __device__ __forceinline__ int lds_byte(int r, int c) { const int st = (r >> 4) * 2 + (c >> 5), rr = r & 15, cc = c & 31, ob = rr * 64 + cc * 2; return st * 1024 + (ob ^ (((ob >> 9) & 1) << 5)); }
__host__ __device__ __forceinline__ void stage_rc(int b, int& R, int& C) { const int st = b / 1024, sb = b % 1024, swz = sb ^ (((sb >> 9) & 1) << 5); R = (st >> 1) * 16 + swz / 64; C = (st & 1) * 32 + (swz % 64) / 2; }
__host__ __device__ __forceinline__ int perm32(int rho) { const int n = rho >> 4, i = rho & 15; return 8 * (i >> 2) + 4 * n + (i & 3); }

struct Unit { int pm, pn; };
struct Gemm { const bf16_t* A; const bf16_t* Bt; int M, N, K; };

struct StaticOrder {
    int nM, nN, nwg, G, c;
    __host__ __device__ void init(int M, int N, int G_, int c_) { nM = M / BM; nN = N / BM; nwg = nM * nN; G = G_; c = c_; }
    __host__ __device__ bool next(int i, Unit& u) const {
        const long L = (long)i * G + c; if (L >= nwg) return false;
        int wgid = (int)L; { const int q = nwg / NXCD, r = nwg % NXCD, xcd = wgid % NXCD, off = wgid / NXCD; wgid = (xcd < r ? xcd * (q + 1) : r * (q + 1) + (xcd - r) * q) + off; }
        const int nig = WGM * nN, gid = wgid / nig, fm = gid * WGM, gsz = (nM - fm) < WGM ? (nM - fm) : WGM;
        u.pm = fm + ((wgid % nig) % gsz); u.pn = (wgid % nig) / gsz; return true;
    }
    __device__ __forceinline__ void a_ready(const Unit&) const {}
    __device__ __forceinline__ void done(const Unit&) const {}
};

__device__ __forceinline__ unsigned cvt_pk_bf16(float lo, float hi) { unsigned r; asm volatile("v_cvt_pk_bf16_f32 %0, %1, %2" : "=v"(r) : "v"(lo), "v"(hi)); return r; }


template <int CTRL> __device__ __forceinline__ float dpp0(float v) { return __builtin_bit_cast(float, __builtin_amdgcn_update_dpp(0, __builtin_bit_cast(int, v), CTRL, 0xf, 0xf, true)); }
__device__ __forceinline__ float row_scan16(float v) { v += dpp0<0x111>(v); v += dpp0<0x112>(v); v += dpp0<0x114>(v); v += dpp0<0x118>(v); return v; }
struct EpiProj {
    static constexpr bool PERM = true, AFTER_DRAIN = false;
    bf16_t* Q; bf16_t* KV; bf16_t* H0; size_t hstride; float* out; float qscale;
    bf16_t* QE; bf16_t* QE2; bf16_t* KLP; bf16_t* KLS; float* EBL; const float* lbv;
    __device__ __forceinline__ void gate_tile(const f32x4 (&acc)[2][2][4][2], const Unit& u, int wr, int wc, int fr, int fq) const {
        const int lane = fq * 16 + fr;
        const int colb = (u.pn - 5) * 128 + wc * 32 + 8 * fq;
        const bool samp = (u.pm == 64);
#pragma unroll
        for (int ai = 0; ai < 2; ++ai) {
#pragma unroll
            for (int n = 0; n < 2; ++n) {
                const f32x4 lb = *(const f32x4*)(lbv + colb + 4 * n);
                float gs[4][4], ff[4][4], tot[4][4];
#pragma unroll
                for (int m = 0; m < 4; ++m)
#pragma unroll
                    for (int i = 0; i < 4; ++i) {
                        const float hf = acc[ai][1][m][n][i];
                        const float sg = __builtin_amdgcn_rcpf(1.0f + __builtin_amdgcn_exp2f(-1.4426950408889634f * hf));
                        const float f = lb[i] + (1.0f - lb[i]) * sg;
                        ff[m][i] = f;
                        const float g = __builtin_amdgcn_logf(f) * 0.6931471805599453f;
                        const float sc = row_scan16(g);
                        gs[m][i] = sc;
                        tot[m][i] = __shfl(sc, lane | 15, 64);
                    }
                float bl[4][4];
#pragma unroll
                for (int i = 0; i < 4; ++i) {
                    if (!samp) {
                        float pre = 0.f;
#pragma unroll
                        for (int m = 0; m < 4; ++m) { gs[m][i] += pre; pre += tot[m][i]; }
#pragma unroll
                        for (int m = 0; m < 4; ++m) bl[m][i] = pre;
                    } else {
#pragma unroll
                        for (int m = 0; m < 4; ++m) bl[m][i] = tot[m][i];
                    }
                }
#pragma unroll
                for (int m = 0; m < 4; ++m) {
                    const int row = u.pm * BM + ai * HALF + wr * 64 + m * 16 + fr;
                    float qe[4], kl[4];
#pragma unroll
                    for (int i = 0; i < 4; ++i) {
                        const float q = acc[ai][0][m][n][i], b = gs[m][i], d = bl[m][i] - b;
                        qe[i] = q * __builtin_amdgcn_exp2f(1.4426950408889634f * b);
                        kl[i] = (1.0f - ff[m][i]) * __builtin_amdgcn_exp2f(1.4426950408889634f * d);
                    }
                    const size_t o = (size_t)row * 1024 + colb + 4 * n;
                    uint2 w;
                    w.x = cvt_pk_bf16(qe[0], qe[1]); w.y = cvt_pk_bf16(qe[2], qe[3]); *(uint2*)(QE + o) = w;
                    w.x = cvt_pk_bf16(kl[0], kl[1]); w.y = cvt_pk_bf16(kl[2], kl[3]);
                    if (row < 16384) *(uint2*)(KLP + o) = w; else *(uint2*)(KLS + (size_t)(row - 16384) * 1024 + colb + 4 * n) = w;
                }
                if (fr == 0) {
                    if (!samp) {
                        const int ci = u.pm * 4 + ai * 2 + wr;
                        f32x4 e, re;
#pragma unroll
                        for (int i = 0; i < 4; ++i) { e[i] = __builtin_amdgcn_exp2f(1.4426950408889634f * bl[0][i]); re[i] = __builtin_amdgcn_exp2f(-1.4426950408889634f * bl[0][i]); }
                        *(f32x4*)(EBL + (size_t)ci * 1024 + colb + 4 * n) = e; *(f32x4*)(EBL + (size_t)(264 + ci) * 1024 + colb + 4 * n) = re;
                    } else if (ai == 0) {
#pragma unroll
                        for (int m = 0; m < 4; ++m) { f32x4 e, re;
#pragma unroll
                            for (int i = 0; i < 4; ++i) { e[i] = __builtin_amdgcn_exp2f(1.4426950408889634f * bl[m][i]); re[i] = __builtin_amdgcn_exp2f(-1.4426950408889634f * bl[m][i]); }
                            *(f32x4*)(EBL + (size_t)(256 + wr * 4 + m) * 1024 + colb + 4 * n) = e; *(f32x4*)(EBL + (size_t)(264 + 256 + wr * 4 + m) * 1024 + colb + 4 * n) = re; }
                    }
                }
            }
        }
    }
    __device__ __forceinline__ void operator()(const f32x4 (&acc)[2][2][4][2], const Unit& u, int wr, int wc, int fr, int fq) const {
        if (u.pn >= 5 && u.pn <= 12) { gate_tile(acc, u, wr, wc, fr, fq); return; }
        const int row0 = u.pm * BM + wr * 64 + fr;
        bf16_t* base; int ldc, c0; float sc = 1.f;
        if (u.pn < 4) { base = Q; ldc = 1024; c0 = u.pn * 256; sc = qscale; }
        else if (u.pn == 4) { base = KV; ldc = 256; c0 = 0; }
        else { const int t = (u.pn - 5) >> 2; base = H0 + (size_t)t * hstride; ldc = 1024; c0 = ((u.pn - 5) & 3) * 256; }
        const int col0 = c0 + wc * 32 + 8 * fq;
#pragma unroll
        for (int ai = 0; ai < 2; ++ai)
#pragma unroll
            for (int m = 0; m < 4; ++m) {
                const int row = row0 + ai * HALF + m * 16;
                bf16_t* rowp = base + (size_t)row * ldc + col0;
#pragma unroll
                for (int bj = 0; bj < 2; ++bj) {
                    const f32x4 v0 = acc[ai][bj][m][0] * sc, v1 = acc[ai][bj][m][1] * sc;
                    u32x4 w; w.x = cvt_pk_bf16(v0[0], v0[1]); w.y = cvt_pk_bf16(v0[2], v0[3]); w.z = cvt_pk_bf16(v1[0], v1[1]); w.w = cvt_pk_bf16(v1[2], v1[3]);
                    *(u32x4*)(rowp + bj * HALF) = w;
                }
                if (u.pn == 4) {
                    int orow = -1; int okb = 0, ovb = 0;
                    if (row < 16384) { const int t = row & 2047; if (t >= 1920) { orow = (row >> 11) * 128 + (t - 1920); okb = O_KP; ovb = O_VP; } }
                    else if (row < 16512) { const int rs = row - 16384; orow = (rs >> 4) * 128 + 112 + (rs & 15); okb = O_KS; ovb = O_VS; }
                    if (orow >= 0) {
                        float* kd = out + okb + (size_t)orow * 128 + wc * 32 + 8 * fq;
                        float* vd = out + ovb + (size_t)orow * 128 + wc * 32 + 8 * fq;
                        *(f32x4*)(kd) = acc[ai][0][m][0]; *(f32x4*)(kd + 4) = acc[ai][0][m][1];
                        *(f32x4*)(vd) = acc[ai][1][m][0]; *(f32x4*)(vd + 4) = acc[ai][1][m][1];
                    }
                }
            }
    }
};

struct EpiOut {
    static constexpr bool PERM = true, AFTER_DRAIN = true;
    const float* x; float* Y1; bf16_t* A2; const float* nw; float* rowsq;
    __device__ __forceinline__ void fused(f32x4 (&acc)[2][2][4][2], const Unit& u, int wr, int wc, int fr, int fq, PG8_LAS unsigned char* lds, int wid, int lane) const {
        PG8_LAS float* P = (PG8_LAS float*)lds;
        const int col0 = u.pn * BM + wc * 32 + 8 * fq;
        f32x4 nwv[2][2];
#pragma unroll
        for (int bj = 0; bj < 2; ++bj)
#pragma unroll
            for (int n = 0; n < 2; ++n) nwv[bj][n] = *(const f32x4*)(nw + col0 + bj * HALF + 4 * n);
#pragma unroll
        for (int ai = 0; ai < 2; ++ai)
#pragma unroll
            for (int m = 0; m < 4; ++m) {
                const int rl = ai * HALF + wr * 64 + m * 16 + fr; const size_t off = (size_t)(u.pm * BM + rl) * 1024 + col0;
                float s = 0.f;
#pragma unroll
                for (int bj = 0; bj < 2; ++bj) {
                    const f32x4 xa = *(const f32x4*)(x + off + bj * HALF), xb = *(const f32x4*)(x + off + bj * HALF + 4);
                    const f32x4 y0 = acc[ai][bj][m][0] + xa, y1 = acc[ai][bj][m][1] + xb;
                    *(f32x4*)(Y1 + off + bj * HALF) = y0; *(f32x4*)(Y1 + off + bj * HALF + 4) = y1;
                    s += (y0[0] * y0[0] + y0[1] * y0[1]) + (y0[2] * y0[2] + y0[3] * y0[3]) + (y1[0] * y1[0] + y1[1] * y1[1]) + (y1[2] * y1[2] + y1[3] * y1[3]);
                    const f32x4 a0 = y0 * nwv[bj][0], a1 = y1 * nwv[bj][1];
                    u32x4 w; w.x = cvt_pk_bf16(a0[0], a0[1]); w.y = cvt_pk_bf16(a0[2], a0[3]); w.z = cvt_pk_bf16(a1[0], a1[1]); w.w = cvt_pk_bf16(a1[2], a1[3]);
                    *(u32x4*)(A2 + off + bj * HALF) = w;
                }
                s += __shfl_xor(s, 16); s += __shfl_xor(s, 32);
                if (fq == 0) P[rl * 4 + wc] = s;
                asm volatile("" ::: "memory");
            }
        asm volatile("s_waitcnt lgkmcnt(0)" ::: "memory"); __builtin_amdgcn_s_barrier(); asm volatile("" ::: "memory");
        const int tid = wid * 64 + lane;
        if (tid < 256) { const float t = (P[tid * 4 + 0] + P[tid * 4 + 1]) + (P[tid * 4 + 2] + P[tid * 4 + 3]); rowsq[(size_t)(u.pm * BM + tid) * 4 + u.pn] = t; }
        asm volatile("s_waitcnt lgkmcnt(0)" ::: "memory"); __builtin_amdgcn_s_barrier(); asm volatile("" ::: "memory");
    }
};

struct EpiGU {
    static constexpr bool PERM = true, AFTER_DRAIN = false;
    bf16_t* ACT; const float* rowsq;
    __device__ __forceinline__ void operator()(const f32x4 (&acc)[2][2][4][2], const Unit& u, int wr, int wc, int fr, int fq) const {
        const int row0 = u.pm * BM + wr * 64 + fr, col0 = u.pn * HALF + wc * 32 + 8 * fq;
#pragma unroll
        for (int ai = 0; ai < 2; ++ai)
#pragma unroll
            for (int m = 0; m < 4; ++m) {
                const int row = row0 + ai * HALF + m * 16;
                const f32x4 p = *(const f32x4*)(rowsq + (size_t)row * 4);
                const float rstd = 1.0f / sqrtf(((p[0] + p[1]) + (p[2] + p[3])) * (1.0f / 1024.0f) + 1e-6f);
                float r[8];
#pragma unroll
                for (int n = 0; n < 2; ++n)
#pragma unroll
                    for (int i = 0; i < 4; ++i) {
                        const float g = acc[ai][0][m][n][i] * rstd, uu = acc[ai][1][m][n][i] * rstd;
                        const float sg = __builtin_amdgcn_rcpf(1.0f + __builtin_amdgcn_exp2f(-1.4426950408889634f * g));
                        r[n * 4 + i] = g * sg * uu;
                    }
                u32x4 w; w.x = cvt_pk_bf16(r[0], r[1]); w.y = cvt_pk_bf16(r[2], r[3]); w.z = cvt_pk_bf16(r[4], r[5]); w.w = cvt_pk_bf16(r[6], r[7]);
                *(u32x4*)(ACT + (size_t)row * 2816 + col0) = w;
            }
    }
};

struct EpiDown {
    static constexpr bool PERM = false, AFTER_DRAIN = false;
    float* Y;
    __device__ __forceinline__ void operator()(const f32x4 (&acc)[2][2][4][2], const Unit& u, int wr, int wc, int fr, int fq) const {
        const int row0 = u.pm * BM + wr * 64 + fr, col0 = u.pn * BM + wc * 32 + 4 * fq;
#pragma unroll
        for (int ai = 0; ai < 2; ++ai)
#pragma unroll
            for (int m = 0; m < 4; ++m) { float* rowp = Y + (size_t)(row0 + ai * HALF + m * 16) * 1024 + col0;
#pragma unroll
                for (int bj = 0; bj < 2; ++bj)
#pragma unroll
                    for (int n = 0; n < 2; ++n) { const f32x4 b = *(const f32x4*)(rowp + bj * HALF + n * 16); *(f32x4*)(rowp + bj * HALF + n * 16) = acc[ai][bj][m][n] + b; }
                if (m & 1) asm volatile("" ::: "memory"); }
    }
};

template <class Epi, class Sched, bool ALIGN_EPI = false, bool SP2 = false>
__device__ __forceinline__ void gemm_phase(PG8_LAS unsigned char* lds, const Gemm g, const Sched& S, const Epi& E) {
    const int tid = threadIdx.x, wid = __builtin_amdgcn_readfirstlane(tid >> 6), lane = tid & 63, wr = wid >> 2, wc = wid & 3, fr = lane & 15, fq = lane >> 4;
    const int K = g.K, nt = K / BK;
    unsigned voffA[2], voffB[2];
#pragma unroll
    for (int i = 0; i < 2; ++i) { int R, C; stage_rc(tid * 16 + i * 8192, R, C); const int Rb = Epi::PERM ? ((R & ~31) + perm32(R & 31)) : R;
        voffA[i] = (unsigned)(R * K + C) * 2u; voffB[i] = (unsigned)(Rb * K + C) * 2u; }
    const size_t kstep = (size_t)(BK * 2);
    const size_t hstep = (size_t)HALF * K * 2;
    const size_t tstep = 2 * hstep;
    const unsigned ldsw = (unsigned)wid * 1024u;
    const int aoff = lds_byte(wr * 64 + fr, fq * 8), boff = lds_byte(wc * 32 + fr, fq * 8);
#define PG8_SA(b, h) (((b) * 2 + (h)) * HTB)
#define PG8_SB(b, h) ((4 + (b) * 2 + (h)) * HTB)
#define PG8_STAGE(bufoff, gbase, voff) do { _Pragma("unroll") for (int _i = 0; _i < 2; ++_i) \
        __builtin_amdgcn_global_load_lds((const unsigned*)((const char*)(gbase) + (voff)[_i]), (PG8_LAS unsigned*)(lds + (bufoff) + ldsw + _i * 8192), 16, 0, 0); } while (0)
#define PG8_LDA(dst, b, h) do { _Pragma("unroll") for (int m = 0; m < 4; ++m) _Pragma("unroll") for (int k = 0; k < 2; ++k) dst[m][k] = *(const PG8_LAS bf16x8*)(lds + PG8_SA(b, h) + aoff + m * 2048 + k * 1024); } while (0)
#define PG8_LDB(dst, b, h) do { _Pragma("unroll") for (int n = 0; n < 2; ++n) _Pragma("unroll") for (int k = 0; k < 2; ++k) dst[n][k] = *(const PG8_LAS bf16x8*)(lds + PG8_SB(b, h) + boff + n * 2048 + k * 1024); } while (0)
#define PG8_MMA(ai, bj, At, Bt) do { __builtin_amdgcn_s_setprio(1); _Pragma("unroll") for (int m = 0; m < 4; ++m) _Pragma("unroll") for (int n = 0; n < 2; ++n) _Pragma("unroll") for (int k = 0; k < 2; ++k) \
        acc[ai][bj][m][n] = __builtin_amdgcn_mfma_f32_16x16x32_bf16(Bt[n][k], At[m][k], acc[ai][bj][m][n], 0, 0, 0); __builtin_amdgcn_s_setprio(0); } while (0)
#define PG8_WAIT_V(n) asm volatile("s_waitcnt vmcnt(" #n ")" ::: "memory")
#define PG8_WAIT_L(n) asm volatile("s_waitcnt lgkmcnt(" #n ")" ::: "memory")
#define PG8_BAR __builtin_amdgcn_s_barrier()
#define PG8_SCHED __builtin_amdgcn_sched_barrier(0)
    Unit cur, nxt; int ui = 0;
    if (!S.next(0, cur)) return;
    f32x4 acc[2][2][4][2];
#pragma unroll
    for (int a = 0; a < 2; ++a)
#pragma unroll
        for (int b = 0; b < 2; ++b)
#pragma unroll
            for (int m = 0; m < 4; ++m)
#pragma unroll
                for (int n = 0; n < 2; ++n) acc[a][b][m][n] = (f32x4){0.f, 0.f, 0.f, 0.f};
    bf16x8 At[4][2], B0[2][2], B1[2][2];
    const char* cA = (const char*)g.A + (size_t)cur.pm * tstep; const char* cB = (const char*)g.Bt + (size_t)cur.pn * tstep;
    S.a_ready(cur);
    if constexpr (SP2) {
        PG8_STAGE(PG8_SB(0, 0), cB, voffB); PG8_STAGE(PG8_SB(0, 1), cB + hstep, voffB); PG8_STAGE(PG8_SA(0, 0), cA, voffA); PG8_STAGE(PG8_SA(0, 1), cA + hstep, voffA);
        if (wr == 1) PG8_BAR;
        PG8_WAIT_V(2); PG8_BAR;
        PG8_STAGE(PG8_SB(1, 0), cB + kstep, voffB); PG8_STAGE(PG8_SA(1, 0), cA + kstep, voffA); PG8_STAGE(PG8_SB(1, 1), cB + hstep + kstep, voffB);
        PG8_WAIT_V(6); PG8_BAR;
    } else {
        PG8_STAGE(PG8_SB(0, 0), cB, voffB); PG8_STAGE(PG8_SA(0, 0), cA, voffA); PG8_STAGE(PG8_SB(0, 1), cB + hstep, voffB); PG8_STAGE(PG8_SA(0, 1), cA + hstep, voffA);
        if (wr == 1) PG8_BAR;
        PG8_WAIT_V(4); PG8_BAR;
        PG8_STAGE(PG8_SB(1, 0), cB + kstep, voffB); PG8_STAGE(PG8_SA(1, 0), cA + kstep, voffA); PG8_STAGE(PG8_SB(1, 1), cB + hstep + kstep, voffB);
        PG8_WAIT_V(6); PG8_BAR;
    }
    for (;;) {
        const bool has_next = S.next(ui + 1, nxt);
        const char* nA = has_next ? (const char*)g.A + (size_t)nxt.pm * tstep : cA; const char* nB = has_next ? (const char*)g.Bt + (size_t)nxt.pn * tstep : cB;
        for (int t = 0; t < nt; t += 2) {
            const bool last = (t == nt - 2);
            const char* a1 = cA + (size_t)(t + 1) * kstep;
            const char* a2 = last ? nA : cA + (size_t)(t + 2) * kstep; const char* b2 = last ? nB : cB + (size_t)(t + 2) * kstep;
            const char* a3 = a2 + kstep; const char* b3 = b2 + kstep;
            if (last && has_next) S.a_ready(nxt);
            if constexpr (SP2) {
            PG8_LDB(B0, 0, 0); PG8_LDB(B1, 0, 1); PG8_SCHED; PG8_LDA(At, 0, 0); PG8_STAGE(PG8_SA(1, 1), a1 + hstep, voffA);
            PG8_WAIT_V(8); PG8_WAIT_L(0); PG8_BAR; PG8_MMA(0, 0, At, B0); PG8_MMA(0, 1, At, B1); PG8_BAR; PG8_SCHED;
            PG8_LDA(At, 0, 1); PG8_STAGE(PG8_SB(0, 0), b2, voffB); PG8_STAGE(PG8_SB(0, 1), b2 + hstep, voffB); PG8_STAGE(PG8_SA(0, 0), a2, voffA);
            PG8_WAIT_V(8); PG8_WAIT_L(0); PG8_BAR; PG8_MMA(1, 0, At, B0); PG8_MMA(1, 1, At, B1); PG8_BAR; PG8_SCHED;
            PG8_LDB(B0, 1, 0); PG8_LDB(B1, 1, 1); PG8_SCHED; PG8_LDA(At, 1, 0); PG8_STAGE(PG8_SA(0, 1), a2 + hstep, voffA);
            PG8_WAIT_V(8); PG8_WAIT_L(0); PG8_BAR; PG8_MMA(0, 0, At, B0); PG8_MMA(0, 1, At, B1); PG8_BAR; PG8_SCHED;
            PG8_LDA(At, 1, 1); PG8_STAGE(PG8_SB(1, 0), b3, voffB); PG8_STAGE(PG8_SB(1, 1), b3 + hstep, voffB); PG8_STAGE(PG8_SA(1, 0), a3, voffA);
            PG8_WAIT_V(8); PG8_WAIT_L(0); PG8_BAR; PG8_MMA(1, 0, At, B0); PG8_MMA(1, 1, At, B1); PG8_BAR; PG8_SCHED;
            } else {
            PG8_LDB(B0, 0, 0); PG8_SCHED; PG8_LDA(At, 0, 0); PG8_STAGE(PG8_SA(1, 1), a1 + hstep, voffA);
            PG8_WAIT_L(8); PG8_BAR; PG8_WAIT_L(0); PG8_MMA(0, 0, At, B0); PG8_BAR; PG8_SCHED;
            PG8_LDB(B1, 0, 1); PG8_STAGE(PG8_SB(0, 0), b2, voffB);
            PG8_BAR; PG8_WAIT_L(0); PG8_MMA(0, 1, At, B1); PG8_BAR;
            PG8_LDA(At, 0, 1); PG8_STAGE(PG8_SA(0, 0), a2, voffA);
            PG8_BAR; PG8_WAIT_L(0); PG8_MMA(1, 0, At, B0); PG8_BAR; PG8_SCHED;
            PG8_STAGE(PG8_SB(0, 1), b2 + hstep, voffB);
            PG8_WAIT_V(6); PG8_BAR; PG8_MMA(1, 1, At, B1); PG8_BAR;
            PG8_LDB(B0, 1, 0); PG8_SCHED; PG8_LDA(At, 1, 0); PG8_STAGE(PG8_SA(0, 1), a2 + hstep, voffA);
            PG8_WAIT_L(8); PG8_BAR; PG8_WAIT_L(0); PG8_MMA(0, 0, At, B0); PG8_BAR; PG8_SCHED;
            PG8_LDB(B1, 1, 1); PG8_STAGE(PG8_SB(1, 0), b3, voffB);
            PG8_BAR; PG8_WAIT_L(0); PG8_MMA(0, 1, At, B1); PG8_BAR;
            PG8_LDA(At, 1, 1); PG8_STAGE(PG8_SA(1, 0), a3, voffA);
            PG8_BAR; PG8_WAIT_L(0); PG8_MMA(1, 0, At, B0); PG8_BAR; PG8_SCHED;
            PG8_STAGE(PG8_SB(1, 1), b3 + hstep, voffB);
            PG8_WAIT_V(6); PG8_BAR; PG8_MMA(1, 1, At, B1); PG8_BAR;
            }
        }
        if constexpr (ALIGN_EPI) { if (wr == 0) PG8_BAR; }
        if constexpr (!Epi::AFTER_DRAIN) { E(acc, cur, wr, wc, fr, fq); S.done(cur); }
        if (!has_next) break;
#pragma unroll
        for (int a = 0; a < 2; ++a)
#pragma unroll
            for (int b = 0; b < 2; ++b)
#pragma unroll
                for (int m = 0; m < 4; ++m)
#pragma unroll
                    for (int n = 0; n < 2; ++n) acc[a][b][m][n] = (f32x4){0.f, 0.f, 0.f, 0.f};
        cur = nxt; cA = nA; cB = nB; ++ui;
        if constexpr (ALIGN_EPI) { if (wr == 1) PG8_BAR; }
    }
    PG8_WAIT_V(0);
    if constexpr (!ALIGN_EPI) { if (wr == 0) PG8_BAR; }
    PG8_BAR;
    if constexpr (Epi::AFTER_DRAIN) { E.fused(acc, cur, wr, wc, fr, fq, lds, wid, lane); S.done(cur); }
#undef PG8_SA
#undef PG8_SB
#undef PG8_STAGE
#undef PG8_LDA
#undef PG8_LDB
#undef PG8_MMA
#undef PG8_WAIT_V
#undef PG8_WAIT_L
#undef PG8_BAR
#undef PG8_SCHED
}
}

constexpr int NWAVES = 8;
constexpr int N_LAUNCHES = MK_N_LAUNCHES;
constexpr int PER_PHASE = 8;
constexpr int D = 1024, NBATCH = 8, SEQ = 2048, MP = NBATCH * SEQ, MS = 128, MROWS = 16640;
constexpr int NIN = 7424, DFF = 2816, NGU = 5632;
constexpr float RMS_EPS = 1e-6f;
constexpr float LOG2E = 1.4426950408889634f;
constexpr float C2 = 0.125f * LOG2E;

constexpr size_t MiB = 1u << 20;
constexpr size_t ACTB = (size_t)MROWS * 1024 * 2;
constexpr size_t WS_CTL = 0, CTL_ZERO_BYTES = 1 * MiB;
constexpr size_t WS_WIN = 1 * MiB;
constexpr size_t WS_Q = 16 * MiB;
constexpr size_t WS_KV = WS_Q + ACTB;
constexpr size_t WS_HQ = WS_KV + 8 * MiB + MiB / 2;
constexpr size_t WS_HF = WS_HQ + ACTB, WS_HI = WS_HF + ACTB, WS_HOG = WS_HI + ACTB, WS_GA = WS_HOG + ACTB, WS_GH = WS_GA + ACTB;
constexpr size_t WS_MISC = WS_GH + ACTB;
constexpr size_t WS_A2 = WS_HQ;
constexpr size_t WS_ACT = WS_HF;
constexpr size_t WS_WOUT = WS_WIN;
constexpr size_t WS_WGU = WS_WOUT + 2 * MiB, WS_WDN = WS_KV;
constexpr size_t WS_SBA = WS_HF;
static_assert(WS_WGU + (size_t)5632 * 1024 * 2 <= WS_Q && WS_WDN + (size_t)1024 * 2816 * 2 <= WS_HQ, "late weights");
static_assert((size_t)1024 * 32768 <= ACTB, "state slots fit GA / XN");
static_assert(WS_ACT + (size_t)MROWS * DFF * 2 <= WS_GA, "ACT inside HF..HOG");
constexpr size_t WS_BIAS = WS_MISC;
constexpr size_t WS_SINK = WS_BIAS + 16 * 256 * 4;
constexpr size_t WS_LB = WS_SINK + 256;
constexpr size_t WS_ROWSQ = WS_MISC + 64 * 1024;
constexpr size_t WS_Y1S = WS_MISC + 512 * 1024;
constexpr size_t WS_KLS = WS_MISC + 1 * MiB;
constexpr size_t WS_EBL = WS_MISC + 1 * MiB + 512 * 1024;
constexpr size_t WS_END = WS_MISC + 4 * MiB;
static_assert(ACTB + (size_t)16384 * 1024 * 2 <= (size_t)O_KP * 4, "KLP inside d_out's y_prompt + y_sample region");
static_assert(WS_END <= 256 * MiB, "d_ws map");

constexpr int CW_TMO = 0, CW_CODE = 1, CW_BAR = 4096;

constexpr int LDS_BYTES = 147456;
constexpr int LDSCTL_OFF = LDS_BYTES - 512, MISC_OFF = LDSCTL_OFF + 320;

#define GAS __attribute__((address_space(1)))
#define LAS __attribute__((address_space(3)))
typedef unsigned short bf16;
typedef unsigned v4u __attribute__((ext_vector_type(4)));
typedef float f32x4 __attribute__((ext_vector_type(4)));
typedef short bf16x8 __attribute__((ext_vector_type(8)));
typedef GAS unsigned gu32;
#define RLX_AGENT __ATOMIC_RELAXED, __HIP_MEMORY_SCOPE_AGENT
#define LDS_WAIT() asm volatile("s_waitcnt lgkmcnt(0)" ::: "memory")
#define VM_WAIT() asm volatile("s_waitcnt vmcnt(0)" ::: "memory")
__device__ __forceinline__ unsigned f2bf(float f) { unsigned u = __builtin_bit_cast(unsigned, f); return (u + 0x7fffu + ((u >> 16) & 1u)) >> 16; }
__device__ __forceinline__ unsigned pk2(float lo, float hi) { return f2bf(lo) | (f2bf(hi) << 16); }
__device__ __forceinline__ float bf2f(unsigned short h) { return __builtin_bit_cast(float, (unsigned)h << 16); }
__device__ __forceinline__ float bflo(unsigned w) { return __builtin_bit_cast(float, w << 16); }
__device__ __forceinline__ float bfhi(unsigned w) { return __builtin_bit_cast(float, w & 0xffff0000u); }
__device__ __forceinline__ float sigmoidf_(float v) { return 1.0f / (1.0f + __expf(-v)); }
__device__ __forceinline__ float fsig(float v) { return __builtin_amdgcn_rcpf(1.0f + __builtin_amdgcn_exp2f(-1.4426950408889634f * v)); }

#define XB_TMO      128
#define XB_XCNT(j)  (256  + 64 * (j))
#define XB_XSUB(j)  (1280 + 64 * (j))
#define XB_XGEN(j)  (2304 + 64 * (j))
#define XB_TOP      3328
#define XB_TOPGEN   3392
#define XCD_BAR_WORDS 3456
#define XB_SPIN_CAP (1u << 18)
__device__ __forceinline__ unsigned xb_ld(unsigned* p)              { return __hip_atomic_load(p, __ATOMIC_RELAXED, __HIP_MEMORY_SCOPE_AGENT); }
__device__ __forceinline__ unsigned xb_add(unsigned* p, unsigned v) { return __hip_atomic_fetch_add(p, v, __ATOMIC_RELAXED, __HIP_MEMORY_SCOPE_AGENT); }
__device__ __forceinline__ unsigned xb_xcc_id() { return (unsigned)__builtin_amdgcn_s_getreg((3 << 11) | 20) & 0xFu; }
#define XB_SPIN(cond, bar) do { unsigned _sp = 0; while (cond) { __builtin_amdgcn_s_sleep(1); \
    if ((++_sp & 255u) == 0u) { if (xb_ld(&(bar)[XB_TMO])) break; if (_sp > XB_SPIN_CAP) { atomicAdd(&(bar)[XB_TMO], 1u); break; } } } } while (0)
struct XcdBarrier { unsigned* bar; unsigned x; volatile LAS unsigned* st; };
__device__ __forceinline__ XcdBarrier xcd_barrier_post(unsigned* bar, volatile LAS unsigned* st) {
    XcdBarrier b; b.bar = bar; b.x = xb_xcc_id(); b.st = st;
    if (threadIdx.x == 0) (void)xb_add(&bar[XB_XCNT(b.x)], 1u);
    return b;
}
__device__ __forceinline__ void xcd_barrier_complete(unsigned* bar, unsigned x, unsigned& nloc, unsigned& nx) {
    const unsigned G = gridDim.x * gridDim.y * gridDim.z;
    unsigned sum, cnt, mine, sp = 0u;
    for (;;) {
        sum = 0u; cnt = 0u; mine = 0u;
#pragma unroll
        for (unsigned j = 0; j < 16; ++j) { const unsigned c = xb_ld(&bar[XB_XCNT(j)]); sum += c; cnt += (c > 0u) ? 1u : 0u; mine = (j == x) ? c : mine; }
        if (sum == G) break;
        __builtin_amdgcn_s_sleep(1);
        if ((++sp & 255u) == 0u) { if (xb_ld(&bar[XB_TMO])) break; if (sp > XB_SPIN_CAP) { atomicAdd(&bar[XB_TMO], 1u); break; } }
    }
    nloc = mine > 0u ? mine : 1u; nx = cnt > 0u ? cnt : 1u;
}
__device__ __forceinline__ void xcd_barrier(const XcdBarrier& b) {
    asm volatile("s_waitcnt vmcnt(0)" ::: "memory");
    __syncthreads();
    if (threadIdx.x == 0) {
        unsigned* bar = b.bar;
        __builtin_amdgcn_s_waitcnt(0);
        unsigned nloc = b.st[0], nx = b.st[1];
        if (nloc == 0u) { xcd_barrier_complete(bar, b.x, nloc, nx); b.st[0] = nloc; b.st[1] = nx; }
        const unsigned old = xb_add(&bar[XB_XSUB(b.x)], 1u);
        const unsigned gen = old / nloc;
        if (old + 1u == (gen + 1u) * nloc) {
            __builtin_amdgcn_fence(__ATOMIC_RELEASE, "agent");
            asm volatile("s_waitcnt vmcnt(0)" ::: "memory");
            const unsigned og = xb_add(&bar[XB_TOP], 1u);
            const unsigned tg = og / nx;
            if (og + 1u == (tg + 1u) * nx) xb_add(&bar[XB_TOPGEN], 1u);
            else XB_SPIN(xb_ld(&bar[XB_TOPGEN]) == tg, bar);
            __builtin_amdgcn_fence(__ATOMIC_ACQUIRE, "agent");
            xb_add(&bar[XB_XGEN(b.x)], 1u);
            asm volatile("s_waitcnt vmcnt(0)" ::: "memory");
        } else {
            XB_SPIN(xb_ld(&bar[XB_XGEN(b.x)]) == gen, bar);
            __builtin_amdgcn_fence(__ATOMIC_ACQUIRE, "agent");
            asm volatile("s_waitcnt vmcnt(0)" ::: "memory");
        }
    }
    __syncthreads();
}

__device__ __forceinline__ float wave_sum(float v) {
#pragma unroll
    for (int o = 1; o < 64; o <<= 1) v += __shfl_xor(v, o);
    return v;
}
__device__ __forceinline__ void transpose_item(const float* W, int K, int N, bf16* WT, int k0, int src_n0, int dst_n0, LAS float* scr, int lane) {
#pragma unroll 8
    for (int i = 0; i < 32; ++i) { const int kk = 2 * i + (lane >> 5); scr[kk * 33 + (lane & 31)] = W[(size_t)(k0 + kk) * N + src_n0 + (lane & 31)]; }
    LDS_WAIT(); asm volatile("" ::: "memory");
    const int c = lane & 7;
#pragma unroll
    for (int j = 0; j < 4; ++j) { const int n = (lane >> 3) + 8 * j; const LAS float* s = scr + (8 * c) * 33 + n;
        v4u o; o.x = pk2(s[0 * 33], s[1 * 33]); o.y = pk2(s[2 * 33], s[3 * 33]); o.z = pk2(s[4 * 33], s[5 * 33]); o.w = pk2(s[6 * 33], s[7 * 33]);
        *(GAS v4u*)(WT + (size_t)(dst_n0 + n) * K + k0 + 8 * c) = o; }
    LDS_WAIT(); asm volatile("" ::: "memory");
}
__device__ __forceinline__ void rms_row_to_bf16(const float* xrow, const float* nw, bf16* orow, int lane) {
    const GAS f32x4* xr = (const GAS f32x4*)xrow + lane; const GAS f32x4* wr4 = (const GAS f32x4*)nw + lane;
    f32x4 v[4]; float s = 0.f;
#pragma unroll
    for (int j = 0; j < 4; ++j) { v[j] = xr[64 * j]; s += (v[j].x * v[j].x + v[j].y * v[j].y) + (v[j].z * v[j].z + v[j].w * v[j].w); }
    const float rstd = 1.f / sqrtf(wave_sum(s) * (1.f / D) + RMS_EPS);
    GAS unsigned long long* o8 = (GAS unsigned long long*)orow + lane;
#pragma unroll
    for (int j = 0; j < 4; ++j) { const f32x4 w = wr4[64 * j];
        o8[64 * j] = (unsigned long long)pk2(v[j].x * rstd * w.x, v[j].y * rstd * w.y) | ((unsigned long long)pk2(v[j].z * rstd * w.z, v[j].w * rstd * w.w) << 32); }
}
__device__ __forceinline__ void rms_row_f32(const float* xrow, const float* nw, float* orow, int lane) {
    const GAS f32x4* xr = (const GAS f32x4*)xrow + lane; const GAS f32x4* wr4 = (const GAS f32x4*)nw + lane;
    f32x4 v[4]; float s = 0.f;
#pragma unroll
    for (int j = 0; j < 4; ++j) { v[j] = xr[64 * j]; s += (v[j].x * v[j].x + v[j].y * v[j].y) + (v[j].z * v[j].z + v[j].w * v[j].w); }
    const float rstd = 1.f / sqrtf(wave_sum(s) * (1.f / D) + RMS_EPS);
    GAS f32x4* o4 = (GAS f32x4*)orow + lane;
#pragma unroll
    for (int j = 0; j < 4; ++j) { const f32x4 w = wr4[64 * j]; o4[64 * j] = v[j] * rstd * w; }
}
__device__ __forceinline__ int t5_bucket(int rel) {
    const int ret = rel > 0 ? 16 : 0; const int n = rel < 0 ? -rel : rel;
    int b;
    if (n < 8) b = n; else if (n < 12) b = 8; else if (n < 16) b = 9; else if (n < 23) b = 10; else if (n < 32) b = 11; else if (n < 46) b = 12; else if (n < 64) b = 13; else if (n < 91) b = 14; else b = 15;
    return ret + b;
}

struct Args { const float* in[16]; float* out; unsigned char* ws; int ph_lo, ph_hi, li, pad; };

template <int MODE>
__device__ __forceinline__ void skinny_item(int item, const bf16* A, const bf16* Bt, int K, const float* xs, float* Y1S, bf16* A2s, const float* nw, float* rowsq_s, float* outs,
                                            LAS unsigned char* lds, int wave, int lane) {
    const int rg = item >> 2, cb = item & 3; const int fr = lane & 15, fq = lane >> 4;
    const bf16* ap = A + (size_t)(rg * 16 + fr) * K + fq * 8;
    const bf16* bp0 = Bt + (size_t)(cb * 256 + wave * 32 + fr) * K + fq * 8;
    const bf16* bp1 = bp0 + (size_t)16 * K;
    f32x4 acc0 = {0.f, 0.f, 0.f, 0.f}, acc1 = {0.f, 0.f, 0.f, 0.f};
#pragma unroll 4
    for (int k = 0; k < K; k += 32) {
        const bf16x8 a = *(const bf16x8*)(ap + k), b0 = *(const bf16x8*)(bp0 + k), b1 = *(const bf16x8*)(bp1 + k);
        acc0 = __builtin_amdgcn_mfma_f32_16x16x32_bf16(a, b0, acc0, 0, 0, 0);
        acc1 = __builtin_amdgcn_mfma_f32_16x16x32_bf16(a, b1, acc1, 0, 0, 0);
    }
    LAS float* P = (LAS float*)lds;
    float ssq[4];
#pragma unroll
    for (int r = 0; r < 4; ++r) {
        const int row = rg * 16 + fq * 4 + r; const int c0 = cb * 256 + wave * 32 + fr, c1 = c0 + 16;
        if (MODE == 0) {
            const float y0 = xs[(size_t)row * 1024 + c0] + acc0[r], y1 = xs[(size_t)row * 1024 + c1] + acc1[r];
            Y1S[(size_t)row * 1024 + c0] = y0; Y1S[(size_t)row * 1024 + c1] = y1;
            A2s[(size_t)row * 1024 + c0] = (bf16)f2bf(y0 * nw[c0]); A2s[(size_t)row * 1024 + c1] = (bf16)f2bf(y1 * nw[c1]);
            ssq[r] = y0 * y0 + y1 * y1;
        } else {
            outs[(size_t)row * 1024 + c0] = Y1S[(size_t)row * 1024 + c0] + acc0[r];
            outs[(size_t)row * 1024 + c1] = Y1S[(size_t)row * 1024 + c1] + acc1[r];
            ssq[r] = 0.f;
        }
    }
    if (MODE == 0) {
#pragma unroll
        for (int r = 0; r < 4; ++r) { float s = ssq[r]; s += __shfl_xor(s, 1); s += __shfl_xor(s, 2); s += __shfl_xor(s, 4); s += __shfl_xor(s, 8); if (fr == 0) P[(fq * 4 + r) * 8 + wave] = s; }
        LDS_WAIT(); __syncthreads();
        if (wave == 0 && lane < 16) { float t = 0.f;
#pragma unroll
            for (int w = 0; w < 8; ++w) t += P[lane * 8 + w];
            rowsq_s[(size_t)(rg * 16 + lane) * 4 + cb] = t; }
        LDS_WAIT(); __syncthreads();
    }
}

typedef short v4i16_t __attribute__((ext_vector_type(4)));
typedef unsigned v2u __attribute__((ext_vector_type(2)));
__device__ __forceinline__ unsigned offb(unsigned row, unsigned ch) { return 256u * row + 16u * (ch ^ (((row & 3u) << 2) | ((row >> 2) & 3u))); }
__device__ __forceinline__ unsigned cvtpk(float lo, float hi) { unsigned r; asm volatile("v_cvt_pk_bf16_f32 %0, %1, %2" : "=v"(r) : "v"(lo), "v"(hi)); return r; }
constexpr int SC_BUF = 32768, SC_EBL = 65536, SC_END = SC_EBL + 1024;
struct ScanItem { int row0, klrow0, nch, nvalid, ebl0; const bf16* KL; const float* S0; float* Sout; unsigned char* sb0; int sbstep; };
__device__ __forceinline__ void scan_stage_load(v4u (&st)[4], f32x4& ste, const float* EBL, const ScanItem& it, int c, int h, const bf16* HI, int tid) {
    if (tid < 32) ste = *(const f32x4*)(EBL + (size_t)(it.ebl0 + c) * 1024 + h * 128 + tid * 4);
#pragma unroll
    for (int k = 0; k < 4; ++k) {
        const int within = tid + 512 * (k & 1), row = within >> 4, ch = within & 15;
        const bf16* src = ((k >> 1) == 0) ? it.KL + (size_t)(it.klrow0 + 64 * c + row) * 1024 : HI + (size_t)(it.row0 + 64 * c + row) * 1024;
        if (row < it.nvalid) st[k] = *(const v4u*)(src + h * 128 + ch * 8); else st[k] = (v4u){0u, 0u, 0u, 0u};
    }
}
__device__ __forceinline__ void scan_stage_write(const v4u (&st)[4], const f32x4& ste, LAS unsigned char* ebuf, LAS unsigned char* buf, int tid) {
    if (tid < 32) *(LAS f32x4*)(ebuf + tid * 16) = ste;
#pragma unroll
    for (int k = 0; k < 4; ++k) { const int within = tid + 512 * (k & 1), row = within >> 4, ch = within & 15; *(LAS v4u*)(buf + (k >> 1) * 16384 + offb(row, ch)) = st[k]; }
}
__device__ __forceinline__ void hgrn_scan(LAS unsigned char* L, const ScanItem it, int h, const bf16* HI, const float* EBL, bool store_first, int tid, int wave, int lane) {
    const int r16_ = lane & 15, q4_ = lane >> 4, w = wave;
    f32x4 S[8];
#pragma unroll
    for (int i = 0; i < 8; ++i)
#pragma unroll
        for (int r = 0; r < 4; ++r) S[i][r] = it.S0 ? it.S0[(size_t)(16 * i + 4 * q4_ + r) * 128 + 16 * w + r16_] : 0.f;
    v4u sa[4], sb_[4]; f32x4 ea = {0.f, 0.f, 0.f, 0.f}, eb = ea;
    scan_stage_load(sa, ea, EBL, it, 0, h, HI, tid);
    __syncthreads();
    scan_stage_write(sa, ea, L + SC_EBL, L, tid);
    if (it.nch > 1) scan_stage_load(sa, ea, EBL, it, 1, h, HI, tid);
    LDS_WAIT(); __syncthreads();
#define SCAN_STEP(c) do { \
        int r16 = r16_, q4 = q4_; asm volatile("" : "+v"(r16), "+v"(q4)); \
        const int tq = r16 >> 2, tp = r16 & 3; \
        LAS unsigned char* B = L + ((c) & 1) * SC_BUF; LAS unsigned char* KLt = B; LAS unsigned char* Vt = B + 16384; \
        if ((c) > 0 || store_first) { \
            unsigned char* sp = it.sb0 + (size_t)(c) * it.sbstep + (16 * w + r16) * 256 + 8 * q4; \
            _Pragma("unroll") for (int i = 0; i < 8; ++i) { v2u wv; wv.x = cvtpk(S[i][0], S[i][1]); wv.y = cvtpk(S[i][2], S[i][3]); *(v2u*)(sp + 32 * i) = wv; } \
        } \
        bf16x8 Vf[2]; \
        _Pragma("unroll") for (int s2 = 0; s2 < 2; ++s2) { \
            const v4i16_t lo = __builtin_amdgcn_ds_read_tr16_b64_v4i16((LAS v4i16_t*)(Vt + offb(32 * s2 + 8 * q4 + tq, 2 * w + (tp >> 1)) + 8 * (tp & 1))); \
            const v4i16_t hi = __builtin_amdgcn_ds_read_tr16_b64_v4i16((LAS v4i16_t*)(Vt + offb(32 * s2 + 8 * q4 + 4 + tq, 2 * w + (tp >> 1)) + 8 * (tp & 1))); \
            Vf[s2] = (bf16x8){lo[0], lo[1], lo[2], lo[3], hi[0], hi[1], hi[2], hi[3]}; } \
        _Pragma("unroll") for (int i = 0; i < 8; ++i) { \
            S[i] = S[i] * *(const LAS f32x4*)(L + SC_EBL + ((c) & 1) * 512 + (16 * i + 4 * q4) * 4); \
            _Pragma("unroll") for (int s2 = 0; s2 < 2; ++s2) { \
                const v4i16_t lo = __builtin_amdgcn_ds_read_tr16_b64_v4i16((LAS v4i16_t*)(KLt + offb(32 * s2 + 8 * q4 + tq, 2 * i + (tp >> 1)) + 8 * (tp & 1))); \
                const v4i16_t hi = __builtin_amdgcn_ds_read_tr16_b64_v4i16((LAS v4i16_t*)(KLt + offb(32 * s2 + 8 * q4 + 4 + tq, 2 * i + (tp >> 1)) + 8 * (tp & 1))); \
                const bf16x8 a = (bf16x8){lo[0], lo[1], lo[2], lo[3], hi[0], hi[1], hi[2], hi[3]}; \
                S[i] = __builtin_amdgcn_mfma_f32_16x16x32_bf16(a, Vf[s2], S[i], 0, 0, 0); } } \
    } while (0)
    for (int c = 0; c < it.nch; c += 2) {
        if (c + 2 < it.nch) scan_stage_load(sb_, eb, EBL, it, c + 2, h, HI, tid);
        SCAN_STEP(c);
        if (c + 1 < it.nch) scan_stage_write(sa, ea, L + SC_EBL + 512, L + SC_BUF, tid);
        LDS_WAIT(); __syncthreads();
        if (c + 1 >= it.nch) break;
        if (c + 3 < it.nch) scan_stage_load(sa, ea, EBL, it, c + 3, h, HI, tid);
        SCAN_STEP(c + 1);
        if (c + 2 < it.nch) scan_stage_write(sb_, eb, L + SC_EBL, L, tid);
        LDS_WAIT(); __syncthreads();
    }
#undef SCAN_STEP
#pragma unroll
    for (int i = 0; i < 8; ++i)
#pragma unroll
        for (int r = 0; r < 4; ++r) it.Sout[(size_t)(16 * i + 4 * q4_ + r) * 128 + 16 * w + r16_] = S[i][r];
}

constexpr int HG_BUF = 65536, HG_A = 131072, HG_RED = 131072 + 8192, HG_END = HG_RED + 2048;
static_assert(HG_END <= LDSCTL_OFF && SC_END <= LDSCTL_OFF, "HGRN LDS map");
struct OutItem { int row0, klrow0, nvalid, h, ebl; const bf16* KL; const unsigned char* sb; };
struct OutCtx { const bf16* QE; const float* REBL; const bf16* HI; const bf16* HOG; const bf16* GH; bf16* MERGED; const bf16* KLP; const bf16* KLS; const unsigned char* SBA; const unsigned char* SBB; };
__device__ __forceinline__ OutItem out_item(int p, const OutCtx& X) {
    OutItem it;
    if (p < 2048) { const int b = p >> 8, h = (p >> 5) & 7, c = p & 31; it.row0 = b * SEQ + c * 64; it.klrow0 = it.row0; it.nvalid = 64; it.h = h; it.KL = X.KLP;
        const int slot = (p >> 5) * 32 + c; it.ebl = b * 32 + c; it.sb = (c == 0) ? nullptr : (slot < 1024 ? X.SBA + (size_t)slot * 32768 : X.SBB + (size_t)(slot - 1024) * 32768); }
    else { const int q = p - 2048, b = q >> 3, h = q & 7; it.row0 = MP + b * 16; it.klrow0 = b * 16; it.nvalid = 16; it.h = h; it.KL = X.KLS; it.ebl = 256 + b;
        const int slot = q * 32; it.sb = slot < 1024 ? X.SBA + (size_t)slot * 32768 : X.SBB + (size_t)(slot - 1024) * 32768; }
    return it;
}
__device__ __forceinline__ void out_stage_load(v4u (&st)[6], f32x4 (&rb)[2], const OutItem& it, const OutCtx& X, int tid) {
    rb[0] = *(const f32x4*)(X.REBL + (size_t)it.ebl * 1024 + it.h * 128 + (tid & 15) * 8); rb[1] = *(const f32x4*)(X.REBL + (size_t)it.ebl * 1024 + it.h * 128 + (tid & 15) * 8 + 4);
#pragma unroll
    for (int k = 0; k < 6; ++k) {
        const int within = tid + 512 * (k & 1), row = within >> 4, ch = within & 15;
        const bf16* src;
        if ((k >> 1) == 0) src = X.QE + (size_t)(it.row0 + row) * 1024;
        else if ((k >> 1) == 1) src = it.KL + (size_t)(it.klrow0 + row) * 1024;
        else src = X.HI + (size_t)(it.row0 + row) * 1024;
        if (row < it.nvalid) st[k] = *(const v4u*)(src + it.h * 128 + ch * 8); else st[k] = (v4u){0u, 0u, 0u, 0u};
    }
}
__device__ __forceinline__ void out_stage_write(const v4u (&st)[6], const f32x4 (&rb)[2], LAS unsigned char* buf, int tid) {
#pragma unroll
    for (int k = 0; k < 6; ++k) { const int within = tid + 512 * (k & 1), row = within >> 4, ch = within & 15;
        const int tile = (k >> 1) == 0 ? 0 : (k >> 1) + 1;
        *(LAS v4u*)(buf + tile * 16384 + offb(row, ch)) = st[k];
        if ((k >> 1) == 0) { v4u q2;
            q2.x = pk2(bflo(st[k].x) * rb[0][0], bfhi(st[k].x) * rb[0][1]); q2.y = pk2(bflo(st[k].y) * rb[0][2], bfhi(st[k].y) * rb[0][3]);
            q2.z = pk2(bflo(st[k].z) * rb[1][0], bfhi(st[k].z) * rb[1][1]); q2.w = pk2(bflo(st[k].w) * rb[1][2], bfhi(st[k].w) * rb[1][3]);
            *(LAS v4u*)(buf + 16384 + offb(row, ch)) = q2; } }
}
__device__ __forceinline__ void hgrn_out(LAS unsigned char* L, const OutCtx X, int p0, int pstep, int pend, const float* gnorm, int tid, int wave, int lane) {
    const int r16_ = lane & 15, q4_ = lane >> 4, w = wave;
    if (p0 >= pend) return;
    float gnv[8];
#pragma unroll
    for (int e2 = 0; e2 < 8; ++e2) gnv[e2] = gnorm[(tid & 15) * 8 + e2];
    v4u st[6]; f32x4 rb[2];
    OutItem it = out_item(p0, X);
    out_stage_load(st, rb, it, X, tid);
    __syncthreads();
    out_stage_write(st, rb, L, tid);
    LDS_WAIT(); __syncthreads();
    int cc = 0;
    for (int p = p0; p < pend; p += pstep, ++cc) {
        int r16 = r16_, q4 = q4_; asm volatile("" : "+v"(r16), "+v"(q4));
        const int tq = r16 >> 2, tp = r16 & 3;
        LAS unsigned char* B = L + (cc & 1) * HG_BUF;
        LAS unsigned char* QEt = B; LAS unsigned char* Q2t = B + 16384; LAS unsigned char* KLt = B + 32768; LAS unsigned char* Vt = B + 49152;
        const bool has_next = p + pstep < pend;
        OutItem nx = it; if (has_next) { nx = out_item(p + pstep, X); out_stage_load(st, rb, nx, X, tid); }
        v4u pf[2][3];
#pragma unroll
        for (int k = 0; k < 2; ++k) { const int within = tid + 512 * k, t = within >> 4, gc = within & 15;
            if (t < it.nvalid) { const size_t gi = (size_t)(it.row0 + t) * 1024 + it.h * 128 + gc * 8;
                pf[k][0] = *(const v4u*)(X.HOG + gi); pf[k][1] = *(const v4u*)(X.GH + gi); pf[k][2] = *(const v4u*)(X.MERGED + gi); }
            else { pf[k][0] = (v4u){0u, 0u, 0u, 0u}; pf[k][1] = pf[k][0]; pf[k][2] = pf[k][0]; } }
        f32x4 o[4];
#pragma unroll
        for (int tt = 0; tt < 4; ++tt) o[tt] = (f32x4){0.f, 0.f, 0.f, 0.f};
        if (it.sb) {
            bf16x8 Sb[4];
#pragma unroll
            for (int s4 = 0; s4 < 4; ++s4) Sb[s4] = *(const bf16x8*)(it.sb + (16 * w + r16) * 256 + (32 * s4 + 8 * q4) * 2);
#pragma unroll
            for (int tt = 0; tt < 4; ++tt) { const unsigned t = 16 * tt + r16;
#pragma unroll
                for (int s4 = 0; s4 < 4; ++s4) {
                    const bf16x8 a = *(const LAS bf16x8*)(QEt + offb(t, 4 * s4 + q4));
                    o[tt] = __builtin_amdgcn_mfma_f32_16x16x32_bf16(a, Sb[s4], o[tt], 0, 0, 0);
                } }
        }
#pragma unroll
        for (int k2 = 0; k2 < 2; ++k2) {
            const int idx = 2 * w + k2, sb = idx >> 2, tb = idx & 3;
            f32x4 cacc = {0.f, 0.f, 0.f, 0.f};
            if (tb >= sb) {
#pragma unroll
                for (int ks = 0; ks < 4; ++ks) {
                    const bf16x8 a = *(const LAS bf16x8*)(KLt + offb(16 * sb + r16, 4 * ks + q4));
                    const bf16x8 bq = *(const LAS bf16x8*)(Q2t + offb(16 * tb + r16, 4 * ks + q4));
                    cacc = __builtin_amdgcn_mfma_f32_16x16x32_bf16(a, bq, cacc, 0, 0, 0);
                }
            }
            const int tval = 16 * tb + r16, s0 = 16 * sb + 4 * q4;
            float v[4];
#pragma unroll
            for (int r = 0; r < 4; ++r) v[r] = (tval >= s0 + r) ? cacc[r] : 0.f;
            v2u wv; wv.x = cvtpk(v[0], v[1]); wv.y = cvtpk(v[2], v[3]);
            *(LAS v2u*)(L + HG_A + tval * 128 + (((s0 >> 3) ^ ((tval >> 1) & 7)) << 4) + (s0 & 7) * 2) = wv;
        }
        LDS_WAIT(); __syncthreads();
        bf16x8 Vf[2];
#pragma unroll
        for (int s2 = 0; s2 < 2; ++s2) {
            const v4i16_t lo = __builtin_amdgcn_ds_read_tr16_b64_v4i16((LAS v4i16_t*)(Vt + offb(32 * s2 + 8 * q4 + tq, 2 * w + (tp >> 1)) + 8 * (tp & 1)));
            const v4i16_t hi = __builtin_amdgcn_ds_read_tr16_b64_v4i16((LAS v4i16_t*)(Vt + offb(32 * s2 + 8 * q4 + 4 + tq, 2 * w + (tp >> 1)) + 8 * (tp & 1)));
            Vf[s2] = (bf16x8){lo[0], lo[1], lo[2], lo[3], hi[0], hi[1], hi[2], hi[3]};
        }
#pragma unroll
        for (int tt = 0; tt < 4; ++tt) { const unsigned t = 16 * tt + r16;
#pragma unroll
            for (int s2 = 0; s2 < 2; ++s2) if (s2 == 0 || tt >= 2) {
                const bf16x8 a = *(const LAS bf16x8*)(L + HG_A + t * 128 + (((4 * s2 + q4) ^ ((t >> 1) & 7)) << 4));
                o[tt] = __builtin_amdgcn_mfma_f32_16x16x32_bf16(a, Vf[s2], o[tt], 0, 0, 0);
            } }
        LAS float* RED = (LAS float*)(L + HG_RED);
        LAS float* OT = (LAS float*)B;
#pragma unroll
        for (int tt = 0; tt < 4; ++tt)
#pragma unroll
            for (int r = 0; r < 4; ++r) { const int t = 16 * tt + 4 * q4 + r; const float ov = o[tt][r];
                OT[t * 128 + 16 * w + r16] = ov;
                float ss = ov * ov; ss += __shfl_xor(ss, 1); ss += __shfl_xor(ss, 2); ss += __shfl_xor(ss, 4); ss += __shfl_xor(ss, 8);
                if (r16 == 0) RED[t * 8 + w] = ss; }
        LDS_WAIT(); __syncthreads();
#pragma unroll
        for (int k = 0; k < 2; ++k) { const int within = tid + 512 * k, t = within >> 4, gc = within & 15;
            if (t < it.nvalid) {
                const f32x4 r0 = *(const LAS f32x4*)(RED + t * 8), r1 = *(const LAS f32x4*)(RED + t * 8 + 4);
                const float tot = ((r0[0] + r0[1]) + (r0[2] + r0[3])) + ((r1[0] + r1[1]) + (r1[2] + r1[3]));
                const float rstd = 1.0f / sqrtf(tot * (1.0f / 128.0f) + RMS_EPS);
                const f32x4 o0 = *(const LAS f32x4*)(OT + t * 128 + gc * 8), o1 = *(const LAS f32x4*)(OT + t * 128 + gc * 8 + 4);
                const float ov[8] = {o0[0], o0[1], o0[2], o0[3], o1[0], o1[1], o1[2], o1[3]};
                const unsigned hw[4] = {pf[k][0].x, pf[k][0].y, pf[k][0].z, pf[k][0].w}, gw_[4] = {pf[k][1].x, pf[k][1].y, pf[k][1].z, pf[k][1].w}, aw[4] = {pf[k][2].x, pf[k][2].y, pf[k][2].z, pf[k][2].w};
                float res[8];
#pragma unroll
                for (int e2 = 0; e2 < 4; ++e2) {
                    const float og0 = bflo(hw[e2]), og1 = bfhi(hw[e2]), gh0 = bflo(gw_[e2]), gh1 = bfhi(gw_[e2]);
                    res[2 * e2] = bflo(aw[e2]) + fsig(gh0) * (ov[2 * e2] * rstd * gnv[2 * e2] * (og0 * fsig(og0)));
                    res[2 * e2 + 1] = bfhi(aw[e2]) + fsig(gh1) * (ov[2 * e2 + 1] * rstd * gnv[2 * e2 + 1] * (og1 * fsig(og1)));
                }
                v4u wv; wv.x = pk2(res[0], res[1]); wv.y = pk2(res[2], res[3]); wv.z = pk2(res[4], res[5]); wv.w = pk2(res[6], res[7]);
                *(v4u*)(X.MERGED + (size_t)(it.row0 + t) * 1024 + it.h * 128 + gc * 8) = wv;
            } }
        if (has_next) out_stage_write(st, rb, L + ((cc + 1) & 1) * HG_BUF, tid);
        LDS_WAIT(); __syncthreads();
        it = nx;
    }
}

typedef float f32x16 __attribute__((ext_vector_type(16)));
constexpr int AT_K = 0, AT_V = 24576, AT_B = 49152, AT_W = 57344, AT_O = 59392, AT_END = 59392 + 65536, AT_CH = 3072, AT_DH = 12288;
static_assert(AT_END <= LDSCTL_OFF, "attention LDS map");
__device__ __forceinline__ int crow16(int r, int hi) { return (r & 3) + 8 * (r >> 2) + 4 * hi; }
__device__ __forceinline__ void attn_unit(LAS unsigned char* L, int unit, const bf16* QB_, const bf16* KVB, const bf16* GAB, bf16* AG, const float* cache_k, const float* cache_v,
                                          const float* BIAS2, const float* SINK2, int tid, int wave, int lane, bool do_store, float* sinkhole) {
    const bool samp = unit >= 512;
    int b, kvh, qrow0, kt0, nks, nqb;
    if (!samp) { b = unit >> 6; const int c = (unit >> 1) & 31; kvh = unit & 1; qrow0 = b * SEQ + c * 64; kt0 = c >= 2 ? 0 : (2 - c) * 2; nks = 12; nqb = 2; }
    else { const int us = unit - 512; b = us >> 1; kvh = us & 1; qrow0 = MP + b * 16; kt0 = 0; nks = 9; nqb = 1; }
    __syncthreads();
    for (int i = tid; i < nks * 16 * 8; i += 512) {
        const int j = i >> 3, ch = i & 7;
        if (j < kt0 * 32) continue;
        v4u kw, vw;
        if (samp && j < 128) {
            const float* kp = cache_k + ((size_t)(b * 128 + j) * 128 + kvh * 64 + ch * 8); const float* vp = cache_v + ((size_t)(b * 128 + j) * 128 + kvh * 64 + ch * 8);
            const f32x4 k0 = *(const f32x4*)kp, k1 = *(const f32x4*)(kp + 4), v0 = *(const f32x4*)vp, v1 = *(const f32x4*)(vp + 4);
            kw.x = pk2(k0[0], k0[1]); kw.y = pk2(k0[2], k0[3]); kw.z = pk2(k1[0], k1[1]); kw.w = pk2(k1[2], k1[3]);
            vw.x = pk2(v0[0], v0[1]); vw.y = pk2(v0[2], v0[3]); vw.z = pk2(v1[0], v1[1]); vw.w = pk2(v1[2], v1[3]);
        } else {
            const size_t row = samp ? (size_t)(MP + b * 16 + (j - 128)) : (size_t)(qrow0 - 128 + j);
            kw = *(const v4u*)(KVB + row * 256 + kvh * 64 + ch * 8); vw = *(const v4u*)(KVB + row * 256 + 128 + kvh * 64 + ch * 8);
        }
        *(LAS v4u*)(L + AT_K + ch * AT_CH + j * 16) = kw;
        *(LAS v4u*)(L + AT_V + (ch >> 2) * AT_DH + j * 64 + (ch & 3) * 16) = vw;
    }
    for (int i = tid; i < 8 * 256; i += 512) ((LAS float*)(L + AT_B))[i] = BIAS2[(kvh * 8 + (i >> 8)) * 256 + (i & 255)];
    LDS_WAIT(); __syncthreads();
    const int r32 = lane & 31, hi = lane >> 5, g = wave, h16 = kvh * 8 + g;
    const float sk = SINK2[h16];
    LAS float* wsf = (LAS float*)(L + AT_W) + g * 64;
    const LAS float* bs = (const LAS float*)(L + AT_B) + g * 256;
    const LAS unsigned char* kb = L + AT_K + hi * AT_CH + r32 * 16;
    const LAS unsigned char* vb = L + AT_V + ((lane >> 4) & 1) * 32 + (lane & 3) * 8 + (4 * hi + ((lane & 15) >> 2)) * 64;
    for (int qb = 0; qb < nqb; ++qb) {
        const int qloc = qb * 32 + r32;
        const size_t qrow = (size_t)qrow0 + (samp ? (qloc & 15) : qloc);
        bf16x8 qr[4];
#pragma unroll
        for (int d0 = 0; d0 < 4; ++d0) qr[d0] = *(const bf16x8*)(QB_ + qrow * 1024 + h16 * 64 + d0 * 16 + hi * 8);
        v4u gaf[4];
#pragma unroll
        for (int k = 0; k < 4; ++k) { const int ql = k * 8 + (lane >> 3), gc = lane & 7;
            gaf[k] = (!samp || ql < 16) ? *(const v4u*)(GAB + ((size_t)qrow0 + qb * 32 + ql) * 1024 + h16 * 64 + gc * 8) : (v4u){0u, 0u, 0u, 0u}; }
        f32x16 p[6];
#pragma unroll
        for (int kt = 0; kt < 6; ++kt) {
            if (kt >= kt0 && 2 * kt < nks) {
#pragma unroll
                for (int r = 0; r < 16; ++r) p[kt][r] = bs[kt * 32 + crow16(r, hi) - qloc + 63];
#pragma unroll
                for (int d0 = 0; d0 < 4; ++d0) {
                    const bf16x8 kf = *(const LAS bf16x8*)(kb + (2 * d0) * AT_CH + kt * 512);
                    p[kt] = __builtin_amdgcn_mfma_f32_32x32x16_bf16(kf, qr[d0], p[kt], 0, 0, 0);
                }
                if (2 * kt + 1 >= nks) {
#pragma unroll
                    for (int r = 8; r < 16; ++r) p[kt][r] = -1e30f;
                }
            }
        }
        float mx = sk;
#pragma unroll
        for (int kt = 0; kt < 6; ++kt) if (kt >= kt0 && 2 * kt < nks) {
#pragma unroll
            for (int r = 0; r < 16; ++r) mx = fmaxf(mx, p[kt][r]); }
        mx = fmaxf(mx, __shfl_xor(mx, 32));
        float l = 0.f;
#pragma unroll
        for (int kt = 0; kt < 6; ++kt) if (kt >= kt0 && 2 * kt < nks) {
#pragma unroll
            for (int r = 0; r < 16; ++r) { const float e = __builtin_amdgcn_exp2f(p[kt][r] - mx); p[kt][r] = e; l += e; } }
        l += __shfl_xor(l, 32);
        l += __builtin_amdgcn_exp2f(sk - mx);
        f32x16 o[2];
#pragma unroll
        for (int r = 0; r < 16; ++r) { o[0][r] = 0.f; o[1][r] = 0.f; }
#pragma unroll
        for (int kt = 0; kt < 6; ++kt) if (kt >= kt0 && 2 * kt < nks) {
#pragma unroll
            for (int s2 = 0; s2 < 2; ++s2) if (2 * kt + s2 < nks) {
                v4u pw; pw.x = cvtpk(p[kt][8 * s2 + 0], p[kt][8 * s2 + 1]); pw.y = cvtpk(p[kt][8 * s2 + 2], p[kt][8 * s2 + 3]); pw.z = cvtpk(p[kt][8 * s2 + 4], p[kt][8 * s2 + 5]); pw.w = cvtpk(p[kt][8 * s2 + 6], p[kt][8 * s2 + 7]);
                const bf16x8 pa = __builtin_bit_cast(bf16x8, pw);
#pragma unroll
                for (int d0 = 0; d0 < 2; ++d0) {
                    const LAS unsigned char* va = vb + d0 * AT_DH + (2 * kt + s2) * 1024;
                    const v4i16_t lo = __builtin_amdgcn_ds_read_tr16_b64_v4i16((LAS v4i16_t*)va);
                    const v4i16_t hv = __builtin_amdgcn_ds_read_tr16_b64_v4i16((LAS v4i16_t*)(va + 512));
                    const bf16x8 vf = (bf16x8){lo[0], lo[1], lo[2], lo[3], hv[0], hv[1], hv[2], hv[3]};
                    o[d0] = __builtin_amdgcn_mfma_f32_32x32x16_bf16(pa, vf, o[d0], 0, 0, 0);
                }
            } }
        if (hi == 0) wsf[r32] = l;
        LDS_WAIT();
        LAS float* ost = (LAS float*)(L + AT_O) + g * 2048;
#pragma unroll
        for (int r = 0; r < 16; ++r) { const float rl = __builtin_amdgcn_rcpf(wsf[crow16(r, hi)]);
            ost[crow16(r, hi) * 64 + r32] = o[0][r] * rl; ost[crow16(r, hi) * 64 + 32 + r32] = o[1][r] * rl; }
        LDS_WAIT();
#pragma unroll
        for (int k = 0; k < 4; ++k) { const int ql = k * 8 + (lane >> 3), gc = lane & 7;
            if (!samp || ql < 16) {
                const f32x4 o0 = *(const LAS f32x4*)(ost + ql * 64 + gc * 8), o1 = *(const LAS f32x4*)(ost + ql * 64 + gc * 8 + 4);
                const unsigned gws[4] = {gaf[k].x, gaf[k].y, gaf[k].z, gaf[k].w};
                v4u wv;
                wv.x = pk2(o0[0] * fsig(bflo(gws[0])), o0[1] * fsig(bfhi(gws[0]))); wv.y = pk2(o0[2] * fsig(bflo(gws[1])), o0[3] * fsig(bfhi(gws[1])));
                wv.z = pk2(o1[0] * fsig(bflo(gws[2])), o1[1] * fsig(bfhi(gws[2]))); wv.w = pk2(o1[2] * fsig(bflo(gws[3])), o1[3] * fsig(bfhi(gws[3])));
                if (do_store) *(v4u*)(AG + ((size_t)qrow0 + qb * 32 + ql) * 1024 + h16 * 64 + gc * 8) = wv; else if (wv.x == 0x12345678u) *sinkhole = 1.f;
            } }
        LDS_WAIT();
    }
}

__global__ void __launch_bounds__(NWAVES * 64, 2) mk_fwd(Args args) {
    extern __shared__ __attribute__((aligned(16))) unsigned char lds[];
    LAS unsigned char* L = (LAS unsigned char*)lds;
    volatile LAS unsigned* MISC = (volatile LAS unsigned*)(L + MISC_OFF);
    const int tid = threadIdx.x, lane = tid & 63, wave = __builtin_amdgcn_readfirstlane(tid >> 6);
    const int G = gridDim.x; const int bx = blockIdx.x;
    const int vcu = (G % 8 == 0) ? (bx % 8) * (G / 8) + bx / 8 : bx;
    unsigned char* ws = args.ws;
    gu32* ctl = (gu32*)(ws + WS_CTL);
    const float* x_prompt = args.in[0]; const float* x_sample = args.in[1]; const float* cache_k = args.in[2]; const float* cache_v = args.in[3];
    const float* state_in = args.in[4]; const float* norm_mix = args.in[5]; const float* w_in = args.in[6]; const float* w_out = args.in[7];
    const float* sinks = args.in[8]; const float* rel_tab = args.in[9]; const float* hgrn_lb = args.in[10]; const float* hgrn_norm = args.in[11];
    const float* norm_ffn = args.in[12]; const float* w_gu = args.in[13]; const float* w_dn = args.in[14]; const float* norm_final = args.in[15];
    float* out = args.out;
    bf16* WinT = (bf16*)(ws + WS_WIN); bf16* WoutT = (bf16*)(ws + WS_WOUT); bf16* WguT = (bf16*)(ws + WS_WGU); bf16* WdnT = (bf16*)(ws + WS_WDN);
    bf16* QB = (bf16*)(ws + WS_Q); bf16* KVB = (bf16*)(ws + WS_KV); bf16* HQB = (bf16*)(ws + WS_HQ); bf16* HFB = (bf16*)(ws + WS_HF); bf16* HIB = (bf16*)(ws + WS_HI);
    bf16* HOGB = (bf16*)(ws + WS_HOG); bf16* GAB = (bf16*)(ws + WS_GA); bf16* GHB = (bf16*)(ws + WS_GH);
    bf16* A2B = (bf16*)(ws + WS_A2); bf16* ACTB_ = (bf16*)(ws + WS_ACT);
    bf16* XN = (bf16*)out;
    float* BIAS2 = (float*)(ws + WS_BIAS); float* SINK2 = (float*)(ws + WS_SINK); float* LBV = (float*)(ws + WS_LB);
    float* ROWSQ = (float*)(ws + WS_ROWSQ); float* Y1S = (float*)(ws + WS_Y1S);
    bf16* KLP = (bf16*)((unsigned char*)out + ACTB); bf16* KLS = (bf16*)(ws + WS_KLS); float* EBL = (float*)(ws + WS_EBL);

    for (int u = tid; u < (LDS_BYTES - LDSCTL_OFF) / 4; u += NWAVES * 64) ((LAS unsigned*)(L + LDSCTL_OFF))[u] = 0u;
    __syncthreads();
    XcdBarrier bar; bar.bar = (unsigned*)(ctl + CW_BAR); bar.x = 0; bar.st = nullptr;
    if (N_LAUNCHES != PER_PHASE) bar = xcd_barrier_post((unsigned*)(ctl + CW_BAR), MISC + 8);
#define GRID_BAR() do { if (N_LAUNCHES != PER_PHASE) { xcd_barrier(bar); } } while (0)
    const int lo = args.ph_lo, hi = args.ph_hi; const int probe = args.pad;
#define IN(k) (lo <= (k) && (k) < hi)
#define BOTH(k) (IN(k) && IN((k) + 1))
    const int gw = vcu * NWAVES + wave, NGW = G * NWAVES;

    if (IN(0)) {
        LAS float* scr = (LAS float*)(L + wave * 16384);
        constexpr int I_IN = (D / 64) * (NIN / 32);
        for (int it = gw; it < I_IN; it += NGW) { const int nblk = NIN / 32, kb = it / nblk, nb = it % nblk; const int n0 = 32 * nb;
            int src = n0;
            if (n0 >= 1280 && n0 < 3328) { const int r = n0 - 1280; src = (((r >> 7) & 1) ? 2304 : 1280) + (r >> 8) * 128 + (r & 127); }
            transpose_item(w_in, D, NIN, WinT, 64 * kb, src, n0, scr, lane); }
        for (int m = gw; m < MROWS; m += NGW) {
            if (m < MP) rms_row_to_bf16(x_prompt + (size_t)m * D, norm_mix, XN + (size_t)m * D, lane);
            else if (m < MP + MS) rms_row_to_bf16(x_sample + (size_t)(m - MP) * D, norm_mix, XN + (size_t)m * D, lane);
            else { GAS unsigned long long* o8 = (GAS unsigned long long*)(XN + (size_t)m * D) + lane;
#pragma unroll
                for (int j = 0; j < 4; ++j) o8[64 * j] = 0ull; }
        }
        const int gt = vcu * (NWAVES * 64) + tid, NGT = G * NWAVES * 64;
        for (int i = gt; i < 16 * 256; i += NGT) { const int h = i >> 8, idx = i & 255; const int rel = idx - 191; BIAS2[i] = (idx < 255) ? rel_tab[t5_bucket(rel) * 16 + h] * LOG2E : 0.f; }
        for (int i = gt; i < 16; i += NGT) SINK2[i] = sinks[i] * LOG2E;
        for (int i = gt; i < 1024; i += NGT) LBV[i] = 1.0f / (1.0f + __expf(hgrn_lb[1024 + i] - hgrn_lb[i]));
        for (int i = gt; i < 8 * 112 * 32; i += NGT) {
            const int b = i / (112 * 32), r = i % (112 * 32), j = r >> 5, c4 = r & 31;
            const f32x4 kv = *(const f32x4*)(cache_k + ((size_t)(b * 128 + 16 + j) * 128 + c4 * 4));
            const f32x4 vv = *(const f32x4*)(cache_v + ((size_t)(b * 128 + 16 + j) * 128 + c4 * 4));
            *(f32x4*)(out + O_KS + ((size_t)(b * 128 + j) * 128 + c4 * 4)) = kv;
            *(f32x4*)(out + O_VS + ((size_t)(b * 128 + j) * 128 + c4 * 4)) = vv;
        }
        for (int i = gt; i < MROWS * 4; i += NGT) ROWSQ[i] = 0.f;
        if (BOTH(0)) GRID_BAR();
    }

    if (IN(1)) {
        pg8::Gemm g{XN, WinT, MROWS, NIN, D}; pg8::StaticOrder S; S.init(MROWS, NIN, G, bx);
        pg8::EpiProj E{QB, KVB, HQB, ACTB / 2, out, C2, HQB, nullptr, KLP, KLS, EBL, LBV};
        pg8::gemm_phase<pg8::EpiProj, pg8::StaticOrder, true, true>(L, g, S, E);
        if constexpr ((PROBE_MASK >> 1) & 1) pg8::gemm_phase<pg8::EpiProj, pg8::StaticOrder, true, true>(L, g, S, E);
        if (BOTH(1)) GRID_BAR();
    }

    if (IN(2)) {
        if ((vcu & 3) == 0) {
            const int item = vcu >> 2, sb = item >> 3, h = item & 7;
            unsigned char* sbp = (item < 32) ? ws + WS_SBA + (size_t)item * 32 * 32768 : (unsigned char*)out + (size_t)(item - 32) * 32 * 32768;
            ScanItem ip{sb * SEQ, sb * SEQ, SEQ / 64, 64, sb * 32, KLP, nullptr, out + O_SP + (size_t)item * 128 * 128, sbp, 32768};
            hgrn_scan(L, ip, h, HIB, EBL, false, tid, wave, lane);
            if constexpr ((PROBE_MASK >> 3) & 1) hgrn_scan(L, ip, h, HIB, EBL, false, tid, wave, lane);
            ScanItem is{MP + sb * 16, sb * 16, 1, 16, 256 + sb, KLS, state_in + (size_t)item * 128 * 128, out + O_SS + (size_t)item * 128 * 128, sbp, 0};
            hgrn_scan(L, is, h, HIB, EBL, true, tid, wave, lane);
        } else {
            const int aw = (vcu >> 2) * 3 + (vcu & 3) - 1, NAW = (G / 4) * 3;
            {
                LAS float* scr = (LAS float*)(L + wave * 16384);
                constexpr int I_O = (D / 64) * (D / 32), I_GU = (D / 64) * (NGU / 32);
                for (int it = aw * NWAVES + wave; it < I_O + I_GU; it += NAW * NWAVES) {
                    int r = it;
                    if (r < I_O) { const int nblk = D / 32, kb = r / nblk, nb = r % nblk; transpose_item(w_out, D, D, WoutT, 64 * kb, 32 * nb, 32 * nb, scr, lane); continue; } r -= I_O;
                    { const int nblk = NGU / 32, kb = r / nblk, nb = r % nblk; const int n0 = 32 * nb;
                      const int src = ((n0 >> 7) & 1) * DFF + (n0 >> 8) * 128 + (n0 & 127);
                      transpose_item(w_gu, D, NGU, WguT, 64 * kb, src, n0, scr, lane); }
                }
            }
            for (int unit = 527 - aw; unit >= 0; unit -= NAW) attn_unit(L, unit, QB, KVB, GAB, QB, cache_k, cache_v, BIAS2, SINK2, tid, wave, lane, true, Y1S);
            if constexpr ((PROBE_MASK >> 2) & 1) for (int unit = 527 - aw; unit >= 0; unit -= NAW) attn_unit(L, unit, QB, KVB, GAB, QB, cache_k, cache_v, BIAS2, SINK2, tid, wave, lane, probe == 12345, Y1S);
        }
        if (BOTH(2)) GRID_BAR();
    }

    if (IN(3)) {
        {
            LAS float* scr = (LAS float*)(L + wave * 16384);
            constexpr int I_DN = (DFF / 64) * (D / 32);
            for (int r = gw; r < I_DN; r += NGW) { const int nblk = D / 32, kb = r / nblk, nb = r % nblk; transpose_item(w_dn, DFF, D, WdnT, 64 * kb, 32 * nb, 32 * nb, scr, lane); }
        }
        OutCtx X{HQB, EBL + (size_t)264 * 1024, HIB, HOGB, GHB, QB, KLP, KLS, ws + WS_SBA, (const unsigned char*)out};
        hgrn_out(L, X, vcu, G, 2048 + 64, hgrn_norm, tid, wave, lane);
        if (BOTH(3)) GRID_BAR();
    }

    if (IN(4)) {
        if (vcu < 32) skinny_item<0>(vcu, QB + (size_t)MP * 1024, WoutT, D, x_sample, Y1S, A2B + (size_t)MP * 1024, norm_ffn, ROWSQ + (size_t)MP * 4, nullptr, L, wave, lane);
        __syncthreads();
        pg8::Gemm g{QB, WoutT, MP, D, D}; pg8::StaticOrder S; S.init(MP, D, G, bx);
        pg8::EpiOut E{x_prompt, out, A2B, norm_ffn, ROWSQ};
        pg8::gemm_phase<pg8::EpiOut, pg8::StaticOrder, false, true>(L, g, S, E);
        if constexpr ((PROBE_MASK >> 4) & 1) pg8::gemm_phase<pg8::EpiOut, pg8::StaticOrder, false, true>(L, g, S, E);
        if (BOTH(4)) GRID_BAR();
    }

    if (IN(5)) {
        pg8::Gemm g{A2B, WguT, MROWS, NGU, D}; pg8::StaticOrder S; S.init(MROWS, NGU, G, bx);
        pg8::EpiGU E{ACTB_, ROWSQ};
        pg8::gemm_phase<pg8::EpiGU, pg8::StaticOrder, true, true>(L, g, S, E);
        if constexpr ((PROBE_MASK >> 5) & 1) pg8::gemm_phase<pg8::EpiGU, pg8::StaticOrder, true, true>(L, g, S, E);
        if (BOTH(5)) GRID_BAR();
    }

    if (IN(6)) {
        if (vcu < 32) skinny_item<1>(vcu, ACTB_ + (size_t)MP * DFF, WdnT, DFF, nullptr, Y1S, nullptr, nullptr, nullptr, out + O_YS, L, wave, lane);
        __syncthreads();
        pg8::Gemm g{ACTB_, WdnT, MP, D, DFF}; pg8::StaticOrder S; S.init(MP, D, G, bx);
        pg8::EpiDown E{out};
        pg8::gemm_phase<pg8::EpiDown, pg8::StaticOrder, false, true>(L, g, S, E);
        if (BOTH(6)) GRID_BAR();
    }

    if (IN(7)) {
        for (int m = gw; m < MP + MS; m += NGW) { float* r = (m < MP) ? out + (size_t)m * D : out + O_YS + (size_t)(m - MP) * D; rms_row_f32(r, norm_final, r, lane); }
    }
#undef IN
#undef BOTH
}

extern "C" void kernel_launch(void* const* d_in, const int* in_sizes, int n_in, void* d_out, int out_size, void* d_ws, size_t ws_size, hipStream_t stream) {
    if (n_in != 16 || ws_size < WS_END) { fprintf(stderr, "kernel_launch: unexpected n_in %d / ws_size %zu\n", n_in, ws_size); return; }
    (void)hipFuncSetAttribute((const void*)mk_fwd, hipFuncAttributeMaxDynamicSharedMemorySize, LDS_BYTES);
    const int grid = 256;
    (void)hipMemsetAsync((char*)d_ws + WS_CTL, 0, CTL_ZERO_BYTES, stream);
    Args a{};
    for (int i = 0; i < 16; ++i) a.in[i] = (const float*)d_in[i];
    a.out = (float*)d_out; a.ws = (unsigned char*)d_ws; a.pad = PROBE_MASK;
    if (N_LAUNCHES == 1) {
        a.ph_lo = 0; a.ph_hi = PER_PHASE; a.li = 0;
        hipLaunchKernelGGL(mk_fwd, dim3(grid), dim3(NWAVES * 64), LDS_BYTES, stream, a);
    } else {
        for (int li = 0; li < PER_PHASE; ++li) { a.ph_lo = li; a.ph_hi = li + 1; a.li = li;
            hipLaunchKernelGGL(mk_fwd, dim3(grid), dim3(NWAVES * 64), LDS_BYTES, stream, a); }
    }
}
```
